# Optimizing an MI355X kernel written in HIP

```python
import math
import jax, jax.numpy as jnp
from jax import lax
import numpy as np

D_MODEL = 1024
BATCH = 16
SEQ = 2048
DEPTH = 2

HEAD_DIM = 64
D_MIX = D_MODEL
POOL_WIDTH = D_MIX // 4
POOL_WINDOWS = (2, 4, 8, 16)
POOL_GROUP = POOL_WIDTH // len(POOL_WINDOWS)
MOBA_WIDTH = D_MIX // 4
MOBA_HEADS = MOBA_WIDTH // HEAD_DIM
MOBA_BLOCK = 256
MOBA_TOPK = 3
MOBA_QCHUNK = 32
DIL_WIDTH = D_MIX // 4
DIL_HEADS = DIL_WIDTH // HEAD_DIM
DILATIONS = ((128, 1), (512, 4), (2048, 16))
CONV_WIDTH = D_MIX - POOL_WIDTH - MOBA_WIDTH - DIL_WIDTH
CONV_KERNEL = 31
ROPE_THETA = 500000.0
ROPE_DIMS = HEAD_DIM // 4
D_FF = 2816
RMS_EPS = 1e-6
LN_EPS = 1e-5
NEG_INF = -1e30
OFF_POOL = 0
OFF_MOBA = OFF_POOL + POOL_WIDTH
OFF_DIL = OFF_MOBA + 3 * MOBA_WIDTH
OFF_CONV = OFF_DIL + 3 * DIL_WIDTH
D_IN = OFF_CONV + 2 * CONV_WIDTH

kernel_name = "hybrid_pool_moba_dilated_conv_macaron"


def rms_norm(x, g):
    xf = x.astype(jnp.float32)
    y = xf * lax.rsqrt(jnp.mean(xf * xf, axis=-1, keepdims=True) + RMS_EPS)
    return (y * g.astype(jnp.float32)).astype(x.dtype)


def layer_norm(x, g, b):
    xf = x.astype(jnp.float32)
    mu = jnp.mean(xf, axis=-1, keepdims=True)
    var = jnp.mean(jnp.square(xf - mu), axis=-1, keepdims=True)
    y = (xf - mu) * lax.rsqrt(var + LN_EPS)
    return (y * g.astype(jnp.float32) + b.astype(jnp.float32)).astype(x.dtype)


def swiglu(x, wg, wu, wd):
    return (jax.nn.silu(x @ wg) * (x @ wu)) @ wd


def rope_tables(positions, dtype):
    inv = ROPE_THETA ** (-jnp.arange(0, ROPE_DIMS, 2, dtype=jnp.float32) / ROPE_DIMS)
    ang = positions.astype(jnp.float32)[..., None] * inv
    return (jnp.cos(ang)[:, :, None, :].astype(dtype), jnp.sin(ang)[:, :, None, :].astype(dtype))


def apply_rope(t, cos, sin):
    half = ROPE_DIMS // 2
    t1 = t[..., :half]
    t2 = t[..., half:ROPE_DIMS]
    return jnp.concatenate([t1 * cos - t2 * sin, t2 * cos + t1 * sin, t[..., ROPE_DIMS:]], axis=-1)


def pool_mixer(u, w, scale):
    B, S, _ = u.shape
    ug = u.reshape(B, S, len(POOL_WINDOWS), POOL_GROUP)
    t_count = jnp.arange(S, dtype=jnp.float32) + 1.0
    outs = []
    for g, wnd in enumerate(POOL_WINDOWS):
        ch = ug[:, :, g].astype(jnp.float32)
        c = jnp.cumsum(ch, axis=1)
        c_back = jnp.pad(c, ((0, 0), (wnd, 0), (0, 0)))[:, :S]
        cnt = jnp.minimum(t_count, float(wnd))[None, :, None]
        outs.append(((c - c_back) / cnt - ch).astype(u.dtype))
    pooled = jnp.stack(outs, axis=2)
    mixed = jnp.einsum('bsgc,gcd->bsgd', pooled, w)
    return mixed.reshape(B, S, POOL_WIDTH) * scale


def moba_attention(q, k, v):
    B, H, S, dh = q.shape
    L = MOBA_BLOCK
    Sp = -(-S // L) * L
    pad = ((0, 0), (0, 0), (0, Sp - S), (0, 0))
    q, k, v = jnp.pad(q, pad), jnp.pad(k, pad), jnp.pad(v, pad)
    NB = Sp // L
    kb = k.reshape(B, H, NB, L, dh)
    vb = v.reshape(B, H, NB, L, dh)
    kmean = jnp.mean(kb.astype(jnp.float32), axis=3)
    gate = jnp.einsum('bhsd,bhnd->bhsn', q.astype(jnp.float32), kmean)
    qblk = jnp.arange(Sp) // L
    past = jnp.arange(NB)[None, :] < qblk[:, None]
    gate = jnp.where(past, gate, NEG_INF)
    topk = min(MOBA_TOPK, NB)
    _, idx = lax.top_k(gate, topk)
    QC = MOBA_QCHUNK
    nc = Sp // QC
    qc = q.reshape(B, H, nc, QC, dh).transpose(2, 0, 1, 3, 4)
    ic = idx.reshape(B, H, nc, QC, topk).transpose(2, 0, 1, 3, 4)
    gather = jax.vmap(jax.vmap(lambda blocks, ii: blocks[ii]))
    scale = HEAD_DIM ** -0.5

    def chunk(args):
        c, qi, ii = args
        start = c * QC
        blk = start // L
        t = start + jnp.arange(QC)
        k_own = lax.dynamic_index_in_dim(kb, blk, axis=2, keepdims=False)
        v_own = lax.dynamic_index_in_dim(vb, blk, axis=2, keepdims=False)
        s_own = jnp.einsum('bhqd,bhkd->bhqk', qi, k_own).astype(jnp.float32) * scale
        kpos = blk * L + jnp.arange(L)
        s_own = jnp.where(kpos[None, :] <= t[:, None], s_own, NEG_INF)
        k_sel = gather(kb, ii)
        v_sel = gather(vb, ii)
        s_sel = jnp.einsum('bhqd,bhqnkd->bhqnk', qi, k_sel).astype(jnp.float32) * scale
        valid = jnp.arange(topk) < blk
        s_sel = jnp.where(valid[:, None], s_sel, NEG_INF)
        logits = jnp.concatenate([s_sel.reshape(B, H, QC, topk * L), s_own], axis=-1)
        p = jax.nn.softmax(logits, axis=-1).astype(qi.dtype)
        p_sel = p[..., :topk * L].reshape(B, H, QC, topk, L)
        p_own = p[..., topk * L:]
        return (jnp.einsum('bhqnk,bhqnkd->bhqd', p_sel, v_sel)
                + jnp.einsum('bhqk,bhkd->bhqd', p_own, v_own))

    out = lax.map(chunk, (jnp.arange(nc), qc, ic))
    out = out.transpose(1, 2, 0, 3, 4).reshape(B, H, Sp, dh)
    return out[:, :, :S]


def dilated_branch(q, k, v, window, dil):
    B, H, S, dh = q.shape
    n = S // dil
    bw = window // dil
    n_p = -(-n // bw) * bw
    nb = n_p // bw

    def to_sub(t):
        t = t.reshape(B, H, n, dil, dh).transpose(0, 1, 3, 2, 4)
        t = jnp.pad(t, ((0, 0), (0, 0), (0, 0), (0, n_p - n), (0, 0)))
        return t.reshape(B, H, dil, nb, bw, dh)

    def with_prev(t):
        prev = jnp.pad(t, ((0, 0), (0, 0), (0, 0), (1, 0), (0, 0), (0, 0)))[:, :, :, :nb]
        return jnp.concatenate([prev, t], axis=4)

    qs = to_sub(q)
    kk = with_prev(to_sub(k))
    vv = with_prev(to_sub(v))
    logits = jnp.einsum('bhrnqd,bhrnkd->bhrnqk', qs, kk).astype(jnp.float32) * (HEAD_DIM ** -0.5)
    qi = jnp.arange(bw)[:, None]
    kj = jnp.arange(2 * bw)[None, :]
    rel = qi + bw - kj
    band = (rel >= 0) & (rel <= bw)
    has_prev = (jnp.arange(nb)[:, None, None] > 0) | (kj[None] >= bw)
    mask = band[None] & has_prev
    logits = jnp.where(mask, logits, NEG_INF)
    m = jnp.max(logits, axis=-1, keepdims=True)
    e = jnp.exp(logits - m)
    den = jnp.sum(e, axis=-1, keepdims=True)
    lse = (m + jnp.log(den))[..., 0]
    p = (e / den).astype(v.dtype)
    out = jnp.einsum('bhrnqk,bhrnkd->bhrnqd', p, vv)
    out = out.reshape(B, H, dil, n_p, dh)[:, :, :, :n].transpose(0, 1, 3, 2, 4).reshape(B, H, S, dh)
    lse = lse.reshape(B, H, dil, n_p)[:, :, :, :n].transpose(0, 1, 3, 2).reshape(B, H, S)
    return out, lse


def dilated_attention(q, k, v):
    outs, lses = [], []
    for window, dil in DILATIONS:
        o, l = dilated_branch(q, k, v, window, dil)
        outs.append(o)
        lses.append(l)
    w = jax.nn.softmax(jnp.stack(lses, axis=0), axis=0)
    o = jnp.stack(outs, axis=0).astype(jnp.float32)
    return jnp.sum(w[..., None] * o, axis=0).astype(q.dtype)


def conv_module(u, conv_w, conv_b, ln_g, ln_b):
    a, g = jnp.split(u, 2, axis=-1)
    h = a * jax.nn.sigmoid(g)
    y = lax.conv_general_dilated(h, conv_w[:, None, :].astype(h.dtype), window_strides=(1,),
                                 padding=((CONV_KERNEL - 1, 0),),
                                 dimension_numbers=('NWC', 'WIO', 'NWC'),
                                 feature_group_count=CONV_WIDTH)
    y = y + conv_b
    return jax.nn.silu(layer_norm(y, ln_g, ln_b))


def to_heads(t, h):
    B, S, _ = t.shape
    return t.reshape(B, S, h, HEAD_DIM)


def setup_inputs(seed: int = 0) -> dict:
    key = jax.random.key(seed)
    ks = jax.random.split(key, 24)
    f32 = jnp.float32

    def nrm(k, shape, fan_in):
        return jax.random.normal(k, shape, f32) * (fan_in ** -0.5)

    def gain(k, shape):
        return 1.0 + 0.05 * jax.random.normal(k, shape, f32)

    x = jax.random.normal(ks[0], (BATCH, SEQ, D_MODEL), f32)
    positions = jnp.arange(SEQ, dtype=jnp.int32)[None, :] + jax.random.randint(ks[1], (BATCH, 1), 0, 4096, jnp.int32)
    return {
        "x": x,
        "positions": positions,
        "ffn1_norm": gain(ks[2], (DEPTH, D_MODEL)),
        "ffn1_gate": nrm(ks[3], (DEPTH, D_MODEL, D_FF), D_MODEL),
        "ffn1_up": nrm(ks[4], (DEPTH, D_MODEL, D_FF), D_MODEL),
        "ffn1_down": nrm(ks[5], (DEPTH, D_FF, D_MODEL), D_FF),
        "mix_norm": gain(ks[6], (DEPTH, D_MODEL)),
        "w_in": nrm(ks[7], (DEPTH, D_MODEL, D_IN), D_MODEL),
        "pool_w": nrm(ks[8], (DEPTH, len(POOL_WINDOWS), POOL_GROUP, POOL_GROUP), POOL_GROUP),
        "pool_scale": 1.0 + 0.1 * jax.random.normal(ks[9], (DEPTH, POOL_WIDTH), f32),
        "conv_w": nrm(ks[10], (DEPTH, CONV_KERNEL, CONV_WIDTH), CONV_KERNEL),
        "conv_b": 0.01 * jax.random.normal(ks[11], (DEPTH, CONV_WIDTH), f32),
        "conv_ln_g": gain(ks[12], (DEPTH, CONV_WIDTH)),
        "conv_ln_b": 0.01 * jax.random.normal(ks[13], (DEPTH, CONV_WIDTH), f32),
        "w_out": nrm(ks[14], (DEPTH, D_MIX, D_MODEL), D_MIX),
        "ffn2_norm": gain(ks[15], (DEPTH, D_MODEL)),
        "ffn2_gate": nrm(ks[16], (DEPTH, D_MODEL, D_FF), D_MODEL),
        "ffn2_up": nrm(ks[17], (DEPTH, D_MODEL, D_FF), D_MODEL),
        "ffn2_down": nrm(ks[18], (DEPTH, D_FF, D_MODEL), D_FF),
        "final_norm": gain(ks[19], (D_MODEL,)),
    }


def reference(x, positions, ffn1_norm, ffn1_gate, ffn1_up, ffn1_down, mix_norm, w_in, pool_w, pool_scale,
              conv_w, conv_b, conv_ln_g, conv_ln_b, w_out, ffn2_norm, ffn2_gate, ffn2_up, ffn2_down, final_norm):
    cos, sin = rope_tables(positions, x.dtype)
    for l in range(DEPTH):
        x = x + 0.5 * swiglu(rms_norm(x, ffn1_norm[l]), ffn1_gate[l], ffn1_up[l], ffn1_down[l])
        h = rms_norm(x, mix_norm[l]) @ w_in[l]
        u_pool = h[..., OFF_POOL:OFF_MOBA]
        qm, km, vm = jnp.split(h[..., OFF_MOBA:OFF_DIL], 3, axis=-1)
        qd, kd, vd = jnp.split(h[..., OFF_DIL:OFF_CONV], 3, axis=-1)
        u_conv = h[..., OFF_CONV:]
        B, S, _ = x.shape
        y_pool = pool_mixer(u_pool, pool_w[l], pool_scale[l])
        qm = apply_rope(to_heads(qm, MOBA_HEADS), cos, sin).transpose(0, 2, 1, 3)
        km = apply_rope(to_heads(km, MOBA_HEADS), cos, sin).transpose(0, 2, 1, 3)
        vm = to_heads(vm, MOBA_HEADS).transpose(0, 2, 1, 3)
        y_moba = moba_attention(qm, km, vm).transpose(0, 2, 1, 3).reshape(B, S, MOBA_WIDTH)
        qd = apply_rope(to_heads(qd, DIL_HEADS), cos, sin).transpose(0, 2, 1, 3)
        kd = apply_rope(to_heads(kd, DIL_HEADS), cos, sin).transpose(0, 2, 1, 3)
        vd = to_heads(vd, DIL_HEADS).transpose(0, 2, 1, 3)
        y_dil = dilated_attention(qd, kd, vd).transpose(0, 2, 1, 3).reshape(B, S, DIL_WIDTH)
        y_conv = conv_module(u_conv, conv_w[l], conv_b[l], conv_ln_g[l], conv_ln_b[l])
        mix = jnp.concatenate([y_pool, y_moba, y_dil, y_conv], axis=-1)
        x = x + mix @ w_out[l]
        x = x + 0.5 * swiglu(rms_norm(x, ffn2_norm[l]), ffn2_gate[l], ffn2_up[l], ffn2_down[l])
    return rms_norm(x, final_norm)
```

```cpp
#include <hip/hip_runtime.h>
#include <hip/hip_cooperative_groups.h>
#include <cstdio>
#include <cstdint>
namespace cg = cooperative_groups;
namespace pg8 {
#define PG8_LAS __attribute__((address_space(3)))
typedef unsigned short bf16_t;
typedef short bf16x8 __attribute__((ext_vector_type(8)));
typedef float f32x4 __attribute__((ext_vector_type(4)));
typedef unsigned u32x4 __attribute__((ext_vector_type(4)));
constexpr int BM = 256, BK = 64, HALF = 128, HTB = HALF * BK * 2  , STAGE_BYTES = 8 * HTB, NXCD = 8, WGM = 8;

__host__ __device__ __forceinline__ int lds_byte(int r, int c) { const int st = (r >> 4) * 2 + (c >> 5), rr = r & 15, cc = c & 31, ob = rr * 64 + cc * 2; return st * 1024 + (ob ^ (((ob >> 9) & 1) << 5)); }
__host__ __device__ __forceinline__ void stage_rc(int b, int& R, int& C) { const int st = b / 1024, sb = b % 1024, swz = sb ^ (((sb >> 9) & 1) << 5); R = (st >> 1) * 16 + swz / 64; C = (st & 1) * 32 + (swz % 64) / 2; }
__host__ __device__ __forceinline__ int perm32(int rho) { const int n = rho >> 4, i = rho & 15; return 8 * (i >> 2) + 4 * n + (i & 3); }

struct Unit { int pm, pn; };
struct Gemm { const bf16_t* A; const bf16_t* Bt; int M, N, K; };

struct StaticOrder {
    int nM, nN, nwg, G, c, rev;
    __host__ __device__ void init(int M, int N, int G_, int c_, int rev_ = 0) { nM = M / BM; nN = N / BM; nwg = nM * nN; G = G_; c = c_; rev = rev_; }
    __host__ __device__ bool next(int i, Unit& u) const {
        const long L = (long)i * G + c; if (L >= nwg) return false;
        int wgid = (int)L; { const int q = nwg / NXCD, r = nwg % NXCD, xcd = wgid % NXCD, off = wgid / NXCD; wgid = (xcd < r ? xcd * (q + 1) : r * (q + 1) + (xcd - r) * q) + off; }
        const int nig = WGM * nN, gid = wgid / nig, fm = gid * WGM, gsz = (nM - fm) < WGM ? (nM - fm) : WGM;
        u.pm = fm + ((wgid % nig) % gsz); u.pn = (wgid % nig) / gsz; if (rev) u.pm = nM - 1 - u.pm; return true;
    }
    __device__ __forceinline__ void a_ready(const Unit&) const {}
    __device__ __forceinline__ void done(const Unit&) const {}
};
__device__ __forceinline__ unsigned cvt_pk_bf16(float lo, float hi) { unsigned r; asm volatile("v_cvt_pk_bf16_f32 %0, %1, %2" : "=v"(r) : "v"(lo), "v"(hi)); return r; }
typedef float f32x2 __attribute__((ext_vector_type(2)));
template <class Epi, class Sched, bool ALIGN_EPI = false, bool SP2 = false>
__device__ __forceinline__ void gemm_phase(PG8_LAS unsigned char* lds, const Gemm g, const Sched& S, const Epi& E) {
    int tid_ = threadIdx.x; asm volatile("" : "+v"(tid_));
    const int tid = tid_, wid = __builtin_amdgcn_readfirstlane(tid >> 6), lane = tid & 63, wr = wid >> 2, wc = wid & 3, fr = lane & 15, fq = lane >> 4;
    const int K = g.K, nt = K / BK;
    unsigned voffA[2], voffB[2];
#pragma unroll
    for (int i = 0; i < 2; ++i) { int R, C; stage_rc(tid * 16 + i * 8192, R, C); const int Rb = Epi::PERM ? ((R & ~31) + perm32(R & 31)) : R;
        voffA[i] = (unsigned)(R * K + C) * 2u; voffB[i] = (unsigned)(Rb * K + C) * 2u; }
    const size_t kstep = (size_t)(BK * 2);
    const size_t hstep = (size_t)HALF * K * 2;
    const size_t tstep = 2 * hstep;
    const unsigned ldsw = (unsigned)wid * 1024u;
    const int aoff = lds_byte(wr * 64 + fr, fq * 8), boff = lds_byte(wc * 32 + fr, fq * 8);
#define PG8_SA(b, h) (((b) * 2 + (h)) * HTB)
#define PG8_SB(b, h) ((4 + (b) * 2 + (h)) * HTB)
#define PG8_STAGE(bufoff, gbase, voff) do { _Pragma("unroll") for (int _i = 0; _i < 2; ++_i) \
        __builtin_amdgcn_global_load_lds((const unsigned*)((const char*)(gbase) + (voff)[_i]), (PG8_LAS unsigned*)(lds + (bufoff) + ldsw + _i * 8192), 16, 0, 0); } while (0)
#define PG8_LDA(dst, b, h) do { _Pragma("unroll") for (int m = 0; m < 4; ++m) _Pragma("unroll") for (int k = 0; k < 2; ++k) dst[m][k] = *(const PG8_LAS bf16x8*)(lds + PG8_SA(b, h) + aoff + m * 2048 + k * 1024); } while (0)
#define PG8_LDB(dst, b, h) do { _Pragma("unroll") for (int n = 0; n < 2; ++n) _Pragma("unroll") for (int k = 0; k < 2; ++k) dst[n][k] = *(const PG8_LAS bf16x8*)(lds + PG8_SB(b, h) + boff + n * 2048 + k * 1024); } while (0)
#define PG8_MMA(ai, bj, At, Bt) do { __builtin_amdgcn_s_setprio(1); _Pragma("unroll") for (int m = 0; m < 4; ++m) _Pragma("unroll") for (int n = 0; n < 2; ++n) _Pragma("unroll") for (int k = 0; k < 2; ++k) \
        acc[ai][bj][m][n] = __builtin_amdgcn_mfma_f32_16x16x32_bf16(Bt[n][k], At[m][k], acc[ai][bj][m][n], 0, 0, 0); __builtin_amdgcn_s_setprio(0); } while (0)
#define PG8_WAIT_V(n) asm volatile("s_waitcnt vmcnt(" #n ")" ::: "memory")
#define PG8_WAIT_L(n) asm volatile("s_waitcnt lgkmcnt(" #n ")" ::: "memory")
#define PG8_BAR __builtin_amdgcn_s_barrier()
#define PG8_SCHED __builtin_amdgcn_sched_barrier(0)
    Unit cur, nxt; int ui = 0;
    if (!S.next(0, cur)) return;
    f32x4 acc[2][2][4][2];
#pragma unroll
    for (int a = 0; a < 2; ++a)
#pragma unroll
        for (int b = 0; b < 2; ++b)
#pragma unroll
            for (int m = 0; m < 4; ++m)
#pragma unroll
                for (int n = 0; n < 2; ++n) acc[a][b][m][n] = (f32x4){0.f, 0.f, 0.f, 0.f};
    bf16x8 At[4][2], B0[2][2], B1[2][2];
    const char* cA = (const char*)g.A + (size_t)cur.pm * tstep; const char* cB = (const char*)g.Bt + (size_t)cur.pn * tstep;
    S.a_ready(cur);
    if constexpr (SP2) {
        PG8_STAGE(PG8_SB(0, 0), cB, voffB); PG8_STAGE(PG8_SB(0, 1), cB + hstep, voffB); PG8_STAGE(PG8_SA(0, 0), cA, voffA); PG8_STAGE(PG8_SA(0, 1), cA + hstep, voffA);
        if (wr == 1) PG8_BAR;
        PG8_WAIT_V(2); PG8_BAR;
        PG8_STAGE(PG8_SB(1, 0), cB + kstep, voffB); PG8_STAGE(PG8_SA(1, 0), cA + kstep, voffA); PG8_STAGE(PG8_SB(1, 1), cB + hstep + kstep, voffB);
        PG8_WAIT_V(6); PG8_BAR;
    } else {
        PG8_STAGE(PG8_SB(0, 0), cB, voffB); PG8_STAGE(PG8_SA(0, 0), cA, voffA); PG8_STAGE(PG8_SB(0, 1), cB + hstep, voffB); PG8_STAGE(PG8_SA(0, 1), cA + hstep, voffA);
        if (wr == 1) PG8_BAR;
        PG8_WAIT_V(4); PG8_BAR;
        PG8_STAGE(PG8_SB(1, 0), cB + kstep, voffB); PG8_STAGE(PG8_SA(1, 0), cA + kstep, voffA); PG8_STAGE(PG8_SB(1, 1), cB + hstep + kstep, voffB);
        PG8_WAIT_V(6); PG8_BAR;
    }
    for (;;) {
        const bool has_next = S.next(ui + 1, nxt);
        const char* nA = has_next ? (const char*)g.A + (size_t)nxt.pm * tstep : cA; const char* nB = has_next ? (const char*)g.Bt + (size_t)nxt.pn * tstep : cB;
        for (int t = 0; t < nt; t += 2) {
            const bool last = (t == nt - 2);
            const char* a1 = cA + (size_t)(t + 1) * kstep;
            const char* a2 = last ? nA : cA + (size_t)(t + 2) * kstep; const char* b2 = last ? nB : cB + (size_t)(t + 2) * kstep;
            const char* a3 = a2 + kstep; const char* b3 = b2 + kstep;
            if (last && has_next) S.a_ready(nxt);
            if constexpr (SP2) {
            PG8_LDB(B0, 0, 0); PG8_LDB(B1, 0, 1); PG8_SCHED; PG8_LDA(At, 0, 0); PG8_STAGE(PG8_SA(1, 1), a1 + hstep, voffA);
            PG8_WAIT_V(8); PG8_WAIT_L(0); PG8_BAR; PG8_MMA(0, 0, At, B0); PG8_MMA(0, 1, At, B1); PG8_BAR; PG8_SCHED;
            PG8_LDA(At, 0, 1); PG8_STAGE(PG8_SB(0, 0), b2, voffB); PG8_STAGE(PG8_SB(0, 1), b2 + hstep, voffB); PG8_STAGE(PG8_SA(0, 0), a2, voffA);
            PG8_WAIT_V(8); PG8_WAIT_L(0); PG8_BAR; PG8_MMA(1, 0, At, B0); PG8_MMA(1, 1, At, B1); PG8_BAR; PG8_SCHED;
            PG8_LDB(B0, 1, 0); PG8_LDB(B1, 1, 1); PG8_SCHED; PG8_LDA(At, 1, 0); PG8_STAGE(PG8_SA(0, 1), a2 + hstep, voffA);
            PG8_WAIT_V(8); PG8_WAIT_L(0); PG8_BAR; PG8_MMA(0, 0, At, B0); PG8_MMA(0, 1, At, B1); PG8_BAR; PG8_SCHED;
            PG8_LDA(At, 1, 1); PG8_STAGE(PG8_SB(1, 0), b3, voffB); PG8_STAGE(PG8_SB(1, 1), b3 + hstep, voffB); PG8_STAGE(PG8_SA(1, 0), a3, voffA);
            PG8_WAIT_V(8); PG8_WAIT_L(0); PG8_BAR; PG8_MMA(1, 0, At, B0); PG8_MMA(1, 1, At, B1); PG8_BAR; PG8_SCHED;
            } else {
            PG8_LDB(B0, 0, 0); PG8_SCHED; PG8_LDA(At, 0, 0); PG8_STAGE(PG8_SA(1, 1), a1 + hstep, voffA);
            PG8_WAIT_L(8); PG8_BAR; PG8_WAIT_L(0); PG8_MMA(0, 0, At, B0); PG8_BAR; PG8_SCHED;
            PG8_LDB(B1, 0, 1); PG8_STAGE(PG8_SB(0, 0), b2, voffB);
            PG8_BAR; PG8_WAIT_L(0); PG8_MMA(0, 1, At, B1); PG8_BAR;
            PG8_LDA(At, 0, 1); PG8_STAGE(PG8_SA(0, 0), a2, voffA);
            PG8_BAR; PG8_WAIT_L(0); PG8_MMA(1, 0, At, B0); PG8_BAR; PG8_SCHED;
            PG8_STAGE(PG8_SB(0, 1), b2 + hstep, voffB);
            PG8_WAIT_V(6); PG8_BAR; PG8_MMA(1, 1, At, B1); PG8_BAR;
            PG8_LDB(B0, 1, 0); PG8_SCHED; PG8_LDA(At, 1, 0); PG8_STAGE(PG8_SA(0, 1), a2 + hstep, voffA);
            PG8_WAIT_L(8); PG8_BAR; PG8_WAIT_L(0); PG8_MMA(0, 0, At, B0); PG8_BAR; PG8_SCHED;
            PG8_LDB(B1, 1, 1); PG8_STAGE(PG8_SB(1, 0), b3, voffB);
            PG8_BAR; PG8_WAIT_L(0); PG8_MMA(0, 1, At, B1); PG8_BAR;
            PG8_LDA(At, 1, 1); PG8_STAGE(PG8_SA(1, 0), a3, voffA);
            PG8_BAR; PG8_WAIT_L(0); PG8_MMA(1, 0, At, B0); PG8_BAR; PG8_SCHED;
            PG8_STAGE(PG8_SB(1, 1), b3 + hstep, voffB);
            PG8_WAIT_V(6); PG8_BAR; PG8_MMA(1, 1, At, B1); PG8_BAR;
            }
        }
        if constexpr (ALIGN_EPI) { if (wr == 0) PG8_BAR; }
        if constexpr (!Epi::AFTER_DRAIN) { E(acc, cur, ui, wr, wc, fr, fq); S.done(cur); }
        if (!has_next) break;
#pragma unroll
        for (int a = 0; a < 2; ++a)
#pragma unroll
            for (int b = 0; b < 2; ++b)
#pragma unroll
                for (int m = 0; m < 4; ++m)
#pragma unroll
                    for (int n = 0; n < 2; ++n) acc[a][b][m][n] = (f32x4){0.f, 0.f, 0.f, 0.f};
        cur = nxt; cA = nA; cB = nB; ++ui;
        if constexpr (ALIGN_EPI) { if (wr == 1) PG8_BAR; }
    }
    PG8_WAIT_V(0);
    if constexpr (!ALIGN_EPI) { if (wr == 0) PG8_BAR; }
    PG8_BAR;
    if constexpr (Epi::AFTER_DRAIN) { E.fused(acc, cur, wr, wc, fr, fq, lds, wid, lane); S.done(cur); }
#undef PG8_SA
#undef PG8_SB
#undef PG8_STAGE
#undef PG8_LDA
#undef PG8_LDB
#undef PG8_MMA
#undef PG8_WAIT_V
#undef PG8_WAIT_L
#undef PG8_BAR
#undef PG8_SCHED
}
}

#define LAS __attribute__((address_space(3)))
typedef unsigned short bf16_t;
typedef short bf16x8 __attribute__((ext_vector_type(8)));
typedef short s16x4 __attribute__((ext_vector_type(4)));
typedef float f32x4 __attribute__((ext_vector_type(4)));
typedef float f32x16 __attribute__((ext_vector_type(16)));
typedef unsigned u32x4 __attribute__((ext_vector_type(4)));
typedef unsigned u32x2 __attribute__((ext_vector_type(2)));

constexpr int BATCH = 16, SEQ = 2048, DM = 1024, DFF = 2816, DIN = 2304, DEPTH = 2, M_TOK = BATCH * SEQ;
constexpr int NWAVES = 8, NTHREADS = 512;
constexpr int LDS_BYTES = 147456;
constexpr float C2 = 0.125f * 1.4426950408889634f;
constexpr float RMS_EPS = 1e-6f, LN_EPS = 1e-5f;
constexpr size_t MiB = 1u << 20;
constexpr size_t WS_BAR = 65536;
constexpr size_t WS_ROPE = 1 * MiB;
constexpr size_t WS_KSUM = 3 * MiB;
constexpr size_t WS_WPT = 3 * MiB + 512 * 1024;
constexpr size_t WS_W = 4 * MiB;
constexpr size_t W_GU = (size_t)2 * DFF * DM * 2, W_D = (size_t)DM * DFF * 2, W_IN = (size_t)DIN * DM * 2, W_OUT = (size_t)DM * DM * 2;
constexpr size_t WO_GU1 = 0, WO_D1 = W_GU, WO_IN = WO_D1 + W_D, WO_OUT = WO_IN + W_IN, WO_GU2 = WO_OUT + W_OUT, WO_D2 = WO_GU2 + W_GU, W_LAYER = WO_D2 + W_D;
constexpr size_t WS_XN = 84 * MiB;
constexpr size_t WS_ACT = 148 * MiB;
constexpr size_t WS_MIX = 324 * MiB;
constexpr size_t WS_SSQ = 388 * MiB;
constexpr size_t WS_END = 390 * MiB;
static_assert(WS_W + DEPTH * W_LAYER <= WS_XN, "weights fit");
static_assert(WS_XN + (size_t)M_TOK * DM * 2 <= WS_ACT && WS_ACT + (size_t)M_TOK * DFF * 2 <= WS_MIX, "ws map");

__device__ __forceinline__ float bf2f(short h) { return __uint_as_float(((unsigned)(unsigned short)h) << 16); }
typedef float f32x2_t __attribute__((ext_vector_type(2))); typedef __bf16 bf16x2_t __attribute__((ext_vector_type(2)));
__device__ __forceinline__ unsigned cvtpk(float lo, float hi) { f32x2_t v = {lo, hi}; bf16x2_t b = __builtin_convertvector(v, bf16x2_t); return __builtin_bit_cast(unsigned, b); }
__device__ __forceinline__ float wave_sum(float v) {
#pragma unroll
    for (int o = 1; o < 64; o <<= 1) v += __shfl_xor(v, o);
    return v;
}
__device__ __forceinline__ float fast_exp2(float x) { return __builtin_amdgcn_exp2f(x); }
__device__ __forceinline__ float sigmoidf_(float x) { return __builtin_amdgcn_rcpf(1.f + fast_exp2(-1.4426950408889634f * x)); }
__device__ __forceinline__ int crow(int r, int hi) { return (r & 3) + 8 * (r >> 2) + 4 * hi; }

namespace pg8 {
constexpr int RC_OFF = 131072 + 2048, RC_UNITS = 12;
__device__ __forceinline__ float row_rstd(const PG8_LAS unsigned char* lds, int ui, int rloc) { return *(const PG8_LAS float*)(lds + RC_OFF + ((ui < RC_UNITS ? ui : 0) * 256 + rloc) * 4); }
__device__ __forceinline__ float row_rstd_global(const float* ssq, int row, int fq) {
    const f32x4 q = *(const f32x4*)(ssq + (size_t)row * 16 + 4 * fq);
    float s = (q[0] + q[1]) + (q[2] + q[3]);
    s += __shfl_xor(s, 16); s += __shfl_xor(s, 32);
    return 1.0f / sqrtf(s * (1.f / DM) + RMS_EPS);
}
template <class Sched> __device__ __forceinline__ void rstd_cache_fill(PG8_LAS unsigned char* lds, const float* ssq, const Sched& S) {
    int tid_ = threadIdx.x; asm volatile("" : "+v"(tid_));
    const int r = tid_ >> 1, h = tid_ & 1;
    PG8_LAS int* pml = (PG8_LAS int*)(lds + RC_OFF - 64);
    if (tid_ < RC_UNITS) { Unit u; u.pm = 0; u.pn = 0; const bool ok = S.next(tid_, u); pml[tid_] = ok ? u.pm : -1; }
    __syncthreads();
    f32x4 qa[RC_UNITS], qb[RC_UNITS]; int pmv[RC_UNITS];
#pragma unroll
    for (int i = 0; i < RC_UNITS; ++i) {
        pmv[i] = pml[i];
        const float* q = ssq + (size_t)((pmv[i] < 0 ? 0 : pmv[i]) * BM + r) * 16 + 8 * h;
        qa[i] = *(const f32x4*)q; qb[i] = *(const f32x4*)(q + 4);
    }
#pragma unroll
    for (int i = 0; i < RC_UNITS; ++i) {
        float s = ((qa[i][0] + qa[i][1]) + (qa[i][2] + qa[i][3])) + ((qb[i][0] + qb[i][1]) + (qb[i][2] + qb[i][3]));
        s += __shfl_xor(s, 1);
        if (h == 0 && pmv[i] >= 0) *(PG8_LAS float*)(lds + RC_OFF + (i * 256 + r) * 4) = 1.0f / sqrtf(s * (1.f / DM) + RMS_EPS);
    }
    __syncthreads();
}
struct EpiSwiGLU {
    static constexpr bool PERM = true, AFTER_DRAIN = false;
    unsigned char* ws; PG8_LAS unsigned char* lds;
    __device__ __forceinline__ void operator()(f32x4 (&acc)[2][2][4][2], const Unit& u, int ui, int wr, int wc, int fr, int fq) const {
        bf16_t* const O = (bf16_t*)(ws + WS_ACT); constexpr int ldc = DFF;
        const int row0 = u.pm * BM + wr * 64 + fr, col0 = u.pn * HALF + wc * 32 + 8 * fq;
        float rsv[2][4];
#pragma unroll
        for (int ai = 0; ai < 2; ++ai)
#pragma unroll
            for (int m = 0; m < 4; ++m) rsv[ai][m] = row_rstd(lds, ui, wr * 64 + fr + ai * HALF + m * 16);
        if (ui >= RC_UNITS) {
#pragma unroll
            for (int ai = 0; ai < 2; ++ai)
#pragma unroll
                for (int m = 0; m < 4; ++m) rsv[ai][m] = row_rstd_global((const float*)(ws + WS_SSQ), u.pm * BM + wr * 64 + fr + ai * HALF + m * 16, fq);
        }
#pragma unroll
        for (int ai = 0; ai < 2; ++ai)
#pragma unroll
            for (int m = 0; m < 4; ++m) {
                bf16_t* rowp = O + (size_t)(row0 + ai * HALF + m * 16) * ldc + col0;
                const float rs = rsv[ai][m];
                float v[8];
#pragma unroll
                for (int n = 0; n < 2; ++n)
#pragma unroll
                    for (int i = 0; i < 4; ++i) { const float g = acc[ai][0][m][n][i] * rs, up = acc[ai][1][m][n][i] * rs; v[n * 4 + i] = g * sigmoidf_(g) * up; }
                u32x4 w; w.x = cvtpk(v[0], v[1]); w.y = cvtpk(v[2], v[3]); w.z = cvtpk(v[4], v[5]); w.w = cvtpk(v[6], v[7]);
                *(u32x4*)rowp = w;
            }
    }
};
struct EpiResid {
    static constexpr bool PERM = false, AFTER_DRAIN = false;
    float* out; unsigned char* ws; int full;
    __device__ __forceinline__ void operator()(f32x4 (&acc)[2][2][4][2], const Unit& u, int ui, int wr, int wc, int fr, int fq) const {
        bf16_t* const xb = (bf16_t*)(ws + WS_XN); float* const ssq = (float*)(ws + WS_SSQ); constexpr int ldc = DM; const float alpha = (full & 2) ? 0.0f : ((full & 1) ? 1.0f : 0.5f);
        const bool wf32 = (full & 4) != 0;
        const int col0 = u.pn * BM + wc * 32 + 4 * fq;
        const int rowb = u.pm * BM + wr * 64 + fr;
        constexpr int RB = 4, NB = 8 / RB;
        u32x2 t[RB][2][2];
#pragma unroll
        for (int j = 0; j < RB; ++j)
#pragma unroll
            for (int bj = 0; bj < 2; ++bj)
#pragma unroll
                for (int n = 0; n < 2; ++n) t[j][bj][n] = *(const u32x2*)(xb + (size_t)(rowb + (j >> 2) * HALF + (j & 3) * 16) * ldc + col0 + bj * HALF + n * 16);
#pragma unroll
        for (int b = 0; b < NB; ++b) {
#pragma unroll
            for (int j = 0; j < RB; ++j) { const int it = b * RB + j, ai = it >> 2, m = it & 3;
#pragma unroll
                for (int bj = 0; bj < 2; ++bj)
#pragma unroll
                    for (int n = 0; n < 2; ++n) { const u32x2 r = t[j][bj][n];
                        const f32x4 bs = {__uint_as_float(r.x << 16), __uint_as_float(r.x & 0xffff0000u), __uint_as_float(r.y << 16), __uint_as_float(r.y & 0xffff0000u)};
                        acc[ai][bj][m][n] = bs + acc[ai][bj][m][n] * alpha; } }
            if (b + 1 < NB) {
#pragma unroll
                for (int j = 0; j < RB; ++j) { const int it = (b + 1) * RB + j;
#pragma unroll
                    for (int bj = 0; bj < 2; ++bj)
#pragma unroll
                        for (int n = 0; n < 2; ++n) t[j][bj][n] = *(const u32x2*)(xb + (size_t)(rowb + (it >> 2) * HALF + (it & 3) * 16) * ldc + col0 + bj * HALF + n * 16); }
            }
#pragma unroll
            for (int j = 0; j < RB; ++j) { const int it = b * RB + j, ai = it >> 2, m = it & 3;
                const int row = rowb + ai * HALF + m * 16;
                const size_t off = (size_t)row * ldc + col0;
                float ss = 0.f;
#pragma unroll
                for (int bj = 0; bj < 2; ++bj)
#pragma unroll
                    for (int n = 0; n < 2; ++n) {
                        const f32x4 v = acc[ai][bj][m][n];
                        if (wf32) *(f32x4*)(out + off + bj * HALF + n * 16) = v;
                        u32x2 w; w.x = cvtpk(v[0], v[1]); w.y = cvtpk(v[2], v[3]);
                        *(u32x2*)(xb + off + bj * HALF + n * 16) = w;
                        ss += (v[0] * v[0] + v[1] * v[1]) + (v[2] * v[2] + v[3] * v[3]);
                    }
                ss += __shfl_xor(ss, 16); ss += __shfl_xor(ss, 32);
                if (fq == 0) ssq[(size_t)row * 16 + 4 * u.pn + wc] = ss;
            }
        }
    }
};
struct EpiH {
    static constexpr bool PERM = true, AFTER_DRAIN = false;
    unsigned char* ws; int layer; PG8_LAS unsigned char* lds;
    __device__ __forceinline__ void operator()(f32x4 (&acc)[2][2][4][2], const Unit& u, int ui, int wr, int wc, int fr, int fq) const {
        bf16_t* const O = (bf16_t*)(ws + WS_ACT); constexpr int ldc = DIN; const float* const rope = (const float*)(ws + WS_ROPE); float* const ksum = (float*)(ws + WS_KSUM) + (size_t)layer * 65536;
        const int pn = u.pn;
        const int row0 = u.pm * BM + wr * 64 + fr;
        const bool is_rope = (pn == 1) | (pn == 2) | (pn == 4) | (pn == 5);
        const bool do_rope = is_rope && ((wc & 1) == 0);
        const float sc = ((pn == 1) | (pn == 4)) ? C2 : 1.f;
        const int col0 = pn * BM + wc * 32 + 8 * fq;
        float rsv[2][4];
#pragma unroll
        for (int ai = 0; ai < 2; ++ai)
#pragma unroll
            for (int m = 0; m < 4; ++m) rsv[ai][m] = row_rstd(lds, ui, wr * 64 + fr + ai * HALF + m * 16);
        if (ui >= RC_UNITS) {
#pragma unroll
            for (int ai = 0; ai < 2; ++ai)
#pragma unroll
                for (int m = 0; m < 4; ++m) rsv[ai][m] = row_rstd_global((const float*)(ws + WS_SSQ), u.pm * BM + wr * 64 + fr + ai * HALF + m * 16, fq);
        }
        f32x4 ks[2][2];
#pragma unroll
        for (int bj = 0; bj < 2; ++bj)
#pragma unroll
            for (int n = 0; n < 2; ++n) ks[bj][n] = (f32x4){0.f, 0.f, 0.f, 0.f};
#pragma unroll
        for (int ai = 0; ai < 2; ++ai)
#pragma unroll
            for (int m = 0; m < 4; ++m) {
                const int row = row0 + ai * HALF + m * 16;
                {   const float rs = rsv[ai][m];
#pragma unroll
                    for (int bj = 0; bj < 2; ++bj) { acc[ai][bj][m][0] *= rs; acc[ai][bj][m][1] *= rs; } }
                if (do_rope) {
                    const float* tb = rope + (size_t)row * 16;
                    f32x4 cs[2], sn[2];
                    cs[0] = *(const f32x4*)(tb); cs[1] = *(const f32x4*)(tb + 4); sn[0] = *(const f32x4*)(tb + 8); sn[1] = *(const f32x4*)(tb + 12);
#pragma unroll
                    for (int bj = 0; bj < 2; ++bj)
#pragma unroll
                        for (int n = 0; n < 2; ++n) {
                            const f32x4 own = acc[ai][bj][m][n]; f32x4 oth;
#pragma unroll
                            for (int i = 0; i < 4; ++i) oth[i] = __shfl_xor(own[i], 16);
                            const f32x4 sg = (fq == 0) ? -sn[n] : sn[n];
                            const f32x4 res = own * cs[n] + oth * sg;
                            if (fq < 2) acc[ai][bj][m][n] = res;
                        }
                }
                bf16_t* rowp = O + (size_t)row * ldc + col0;
#pragma unroll
                for (int bj = 0; bj < 2; ++bj) {
                    ks[bj][0] += acc[ai][bj][m][0]; ks[bj][1] += acc[ai][bj][m][1];
                    const f32x4 v0 = acc[ai][bj][m][0] * sc, v1 = acc[ai][bj][m][1] * sc;
                    u32x4 w; w.x = cvtpk(v0[0], v0[1]); w.y = cvtpk(v0[2], v0[3]); w.z = cvtpk(v1[0], v1[1]); w.w = cvtpk(v1[2], v1[3]);
                    *(u32x4*)(rowp + bj * HALF) = w;
                }
                asm volatile("" ::: "memory");
            }
        if (pn == 2) {
#pragma unroll
            for (int bj = 0; bj < 2; ++bj)
#pragma unroll
                for (int n = 0; n < 2; ++n) {
                    f32x4 s = ks[bj][n];
#pragma unroll
                    for (int i = 0; i < 4; ++i) { float t = s[i]; t += __shfl_xor(t, 1); t += __shfl_xor(t, 2); t += __shfl_xor(t, 4); t += __shfl_xor(t, 8); s[i] = t; }
                    if (fr == 0) *(f32x4*)(ksum + (size_t)(u.pm * 2 + wr) * 256 + bj * HALF + wc * 32 + 8 * fq + 4 * n) = s;
                }
        }
    }
};
}

__device__ __forceinline__ void transpose_item(const float* W, int K, int N, bf16_t* WT, int mode, LAS float* scr, int item, int lane, const float* gain) {
    const int nblk = N / 32, kb = item / nblk, nb = item % nblk, k0 = 64 * kb, n0 = 32 * nb;
    const int rbase = (mode == 0) ? n0 : (256 * (nb >> 2) + 32 * (nb & 3) + (mode == 2 ? 128 : 0));
    {
        float tv[32], gq[32];
        const float* src = W + (size_t)(k0 + (lane >> 5)) * N + n0 + (lane & 31);
#pragma unroll
        for (int i = 0; i < 32; ++i) tv[i] = src[(size_t)(2 * i) * N];
#pragma unroll
        for (int i = 0; i < 32; ++i) gq[i] = gain ? gain[k0 + 2 * i + (lane >> 5)] : 1.0f;
#pragma unroll
        for (int i = 0; i < 32; ++i) scr[(2 * i + (lane >> 5)) * 33 + (lane & 31)] = tv[i] * gq[i];
    }
    asm volatile("s_waitcnt lgkmcnt(0)" ::: "memory");
    const int c = lane & 7;
#pragma unroll
    for (int j = 0; j < 4; ++j) { const int n = (lane >> 3) + 8 * j; const LAS float* s = scr + (8 * c) * 33 + n;
        u32x4 o; o.x = cvtpk(s[0 * 33], s[1 * 33]); o.y = cvtpk(s[2 * 33], s[3 * 33]); o.z = cvtpk(s[4 * 33], s[5 * 33]); o.w = cvtpk(s[6 * 33], s[7 * 33]);
        *(u32x4*)(WT + (size_t)(rbase + n) * K + k0 + 8 * c) = o; }
    asm volatile("s_waitcnt lgkmcnt(0)" ::: "memory");
}
__device__ __forceinline__ void sincos_acc(float ang, float& c, float& s) {
    const double a = (double)ang;
    const double k = __builtin_rint(a * 0.63661977236758134308);
    double r = __builtin_fma(-k, 1.57079632679489655800, a);
    r = __builtin_fma(-k, 6.12323399573676603587e-17, r);
    const float x = (float)r, x2 = x * x;
    const float sp = x + x * x2 * (-1.6666667e-1f + x2 * (8.3333333e-3f + x2 * (-1.9841270e-4f + x2 * 2.7557319e-6f)));
    const float cp = 1.f + x2 * (-0.5f + x2 * (4.1666667e-2f + x2 * (-1.3888889e-3f + x2 * (2.4801587e-5f + x2 * (-2.7557319e-7f)))));
    const int q = ((int)k) & 3;
    const float s0 = (q & 1) ? cp : sp, c0 = (q & 1) ? sp : cp;
    s = (q & 2) ? -s0 : s0;
    c = (q == 1 || q == 2) ? -c0 : c0;
}
struct Args { const float* in[20]; float* out; unsigned char* ws; int ph_lo, ph_hi; };

__device__ __forceinline__ void prologue(const Args& A, LAS unsigned char* lds, int gw, int NGW, int wave, int lane) {
    LAS float* scr = (LAS float*)(lds + wave * 16384);
    constexpr int I_G = (DM / 64) * (DFF / 32), I_D = (DFF / 64) * (DM / 32), I_IN = (DM / 64) * (DIN / 32), I_OUT = (DM / 64) * (DM / 32);
    constexpr int I_LAYER = 6 * I_G + I_IN + I_OUT;
    static_assert(I_D == I_G, "item counts");
    for (int it = gw; it < DEPTH * I_LAYER; it += NGW) {
        const int l = it / I_LAYER; int r = it % I_LAYER;
        unsigned char* wl = A.ws + WS_W + (size_t)l * W_LAYER;
        if (r < I_G) { transpose_item(A.in[3] + (size_t)l * DM * DFF, DM, DFF, (bf16_t*)(wl + WO_GU1), 1, scr, r, lane, A.in[2] + (size_t)l * DM); continue; } r -= I_G;
        if (r < I_G) { transpose_item(A.in[4] + (size_t)l * DM * DFF, DM, DFF, (bf16_t*)(wl + WO_GU1), 2, scr, r, lane, A.in[2] + (size_t)l * DM); continue; } r -= I_G;
        if (r < I_G) { transpose_item(A.in[5] + (size_t)l * DFF * DM, DFF, DM, (bf16_t*)(wl + WO_D1), 0, scr, r, lane, nullptr); continue; } r -= I_G;
        if (r < I_G) { transpose_item(A.in[16] + (size_t)l * DM * DFF, DM, DFF, (bf16_t*)(wl + WO_GU2), 1, scr, r, lane, A.in[15] + (size_t)l * DM); continue; } r -= I_G;
        if (r < I_G) { transpose_item(A.in[17] + (size_t)l * DM * DFF, DM, DFF, (bf16_t*)(wl + WO_GU2), 2, scr, r, lane, A.in[15] + (size_t)l * DM); continue; } r -= I_G;
        if (r < I_G) { transpose_item(A.in[18] + (size_t)l * DFF * DM, DFF, DM, (bf16_t*)(wl + WO_D2), 0, scr, r, lane, nullptr); continue; } r -= I_G;
        if (r < I_IN) { transpose_item(A.in[7] + (size_t)l * DM * DIN, DM, DIN, (bf16_t*)(wl + WO_IN), 0, scr, r, lane, A.in[6] + (size_t)l * DM); continue; } r -= I_IN;
        transpose_item(A.in[14] + (size_t)l * DM * DM, DM, DM, (bf16_t*)(wl + WO_OUT), 0, scr, r, lane, nullptr);
    }
    {   bf16_t* XB = (bf16_t*)(A.ws + WS_XN); float* SSQ = (float*)(A.ws + WS_SSQ); const float* X0 = A.in[0];
        const int c3 = blockIdx.x, g3 = gridDim.x;
        const int m0 = (g3 == 256) ? 4096 * (c3 & 7) + (c3 >> 3) * 8 + wave : gw;
        const int ms = (g3 == 256) ? 256 : NGW;
        const int me = (g3 == 256) ? 4096 * (c3 & 7) + 4096 : M_TOK;
        for (int mb = m0; mb < me; mb += 4 * ms) {
            f32x4 v[4][4];
#pragma unroll
            for (int q = 0; q < 4; ++q) { const int m = (mb + q * ms < me) ? mb + q * ms : mb; const f32x4* xr = (const f32x4*)(X0 + (size_t)m * DM) + lane;
#pragma unroll
                for (int j = 0; j < 4; ++j) v[q][j] = xr[64 * j]; }
#pragma unroll
            for (int q = 0; q < 4; ++q) { const int m = mb + q * ms; if (m < me) {
                float s = 0.f;
#pragma unroll
                for (int j = 0; j < 4; ++j) s += (v[q][j].x * v[q][j].x + v[q][j].y * v[q][j].y) + (v[q][j].z * v[q][j].z + v[q][j].w * v[q][j].w);
                s = wave_sum(s);
                u32x2* o8 = (u32x2*)(XB + (size_t)m * DM) + lane;
#pragma unroll
                for (int j = 0; j < 4; ++j) { u32x2 w; w.x = cvtpk(v[q][j].x, v[q][j].y); w.y = cvtpk(v[q][j].z, v[q][j].w); o8[64 * j] = w; }
                if (lane < 16) SSQ[(size_t)m * 16 + lane] = (lane == 0) ? s : 0.f; } }
        } }
    const int gt = gw * 64 + lane, NGT = NGW * 64;
    { bf16_t* wpt = (bf16_t*)(A.ws + WS_WPT); const float* pw = A.in[8];
      for (int o = gt; o < DEPTH * 4 * 64 * 64; o += NGT) { const int c = o & 63, d = (o >> 6) & 63, lg = o >> 12; wpt[o] = (bf16_t)(cvtpk(pw[(size_t)lg * 4096 + c * 64 + d], 0.f) & 0xffffu); } }
    { float* rt = (float*)(A.ws + WS_ROPE); const int* pos = (const int*)A.in[1];
      for (int o = gt; o < M_TOK * 8; o += NGT) { const int tok = o >> 3, i = o & 7;
          const float inv = (i == 0) ? 1.0f : (i == 1) ? 0.19392274f : (i == 2) ? 0.03760603f : (i == 3) ? 0.0072926646f : (i == 4) ? 0.0014142136f : (i == 5) ? 0.0002742482f : (i == 6) ? 5.3182957e-05f : 1.0313385e-05f;
          const float ang = (float)pos[tok] * inv; float c, s; sincos_acc(ang, c, s);
          rt[(size_t)tok * 16 + i] = c; rt[(size_t)tok * 16 + 8 + i] = s; } }
}

__device__ __forceinline__ void norm_rows_bf16(const float* X, const float* g, bf16_t* XN, int gw, int NGW, int lane) {
    f32x4 gv[4];
#pragma unroll
    for (int j = 0; j < 4; ++j) gv[j] = ((const f32x4*)g)[lane + 64 * j];
    for (int m = gw; m < M_TOK; m += NGW) {
        const f32x4* xr = (const f32x4*)(X + (size_t)m * DM) + lane; f32x4 v[4]; float s = 0.f;
#pragma unroll
        for (int j = 0; j < 4; ++j) { v[j] = xr[64 * j]; s += (v[j].x * v[j].x + v[j].y * v[j].y) + (v[j].z * v[j].z + v[j].w * v[j].w); }
        const float rstd = 1.0f / sqrtf(wave_sum(s) * (1.f / DM) + RMS_EPS);
        u32x2* o8 = (u32x2*)(XN + (size_t)m * DM) + lane;
#pragma unroll
        for (int j = 0; j < 4; ++j) { const f32x4 y = v[j] * rstd * gv[j]; u32x2 w; w.x = cvtpk(y.x, y.y); w.y = cvtpk(y.z, y.w); o8[64 * j] = w; }
    }
}
__device__ __forceinline__ void norm_rows_f32(const float* X, const float* g, float* OUT, int gw, int NGW, int lane) {
    f32x4 gv[4];
#pragma unroll
    for (int j = 0; j < 4; ++j) gv[j] = ((const f32x4*)g)[lane + 64 * j];
    for (int m = gw; m < M_TOK; m += NGW) {
        const f32x4* xr = (const f32x4*)(X + (size_t)m * DM) + lane; f32x4 v[4]; float s = 0.f;
#pragma unroll
        for (int j = 0; j < 4; ++j) { v[j] = xr[64 * j]; s += (v[j].x * v[j].x + v[j].y * v[j].y) + (v[j].z * v[j].z + v[j].w * v[j].w); }
        const float rstd = 1.0f / sqrtf(wave_sum(s) * (1.f / DM) + RMS_EPS);
        f32x4* o = (f32x4*)(OUT + (size_t)m * DM) + lane;
#pragma unroll
        for (int j = 0; j < 4; ++j) o[64 * j] = v[j] * rstd * gv[j];
    }
}

constexpr int PTR_OFF = 131072 + 1024;
__device__ __forceinline__ const float* ldptr(LAS unsigned char* lds, int i) {
    const unsigned long long v = *(volatile LAS unsigned long long*)(lds + PTR_OFF + 8 * i);
    const unsigned lo = __builtin_amdgcn_readfirstlane((unsigned)v), hi = __builtin_amdgcn_readfirstlane((unsigned)(v >> 32));
    return (const float*)(const __attribute__((address_space(1))) float*)(((unsigned long long)hi << 32) | lo);
}
__device__ __forceinline__ void norm_rows_final(const bf16_t* XB, const float* SSQ, const float* g, float* OUT, int m0, int mstride, int mend, int lane) {
    f32x4 gv[4];
#pragma unroll
    for (int j = 0; j < 4; ++j) gv[j] = ((const f32x4*)g)[lane + 64 * j];
    for (int mb = m0; mb < mend; mb += 4 * mstride) {
        u32x2 v[4][4]; float sq[4];
#pragma unroll
        for (int q = 0; q < 4; ++q) { const int m = (mb + q * mstride < mend) ? mb + q * mstride : mb; const u32x2* xr = (const u32x2*)(XB + (size_t)m * DM) + lane;
#pragma unroll
            for (int j = 0; j < 4; ++j) v[q][j] = xr[64 * j];
            sq[q] = (lane < 16) ? SSQ[(size_t)m * 16 + lane] : 0.f; }
#pragma unroll
        for (int q = 0; q < 4; ++q) { const int m = mb + q * mstride; if (m < mend) {
            float s = sq[q];
            s += __shfl_xor(s, 1); s += __shfl_xor(s, 2); s += __shfl_xor(s, 4); s += __shfl_xor(s, 8);
            s = __shfl(s, 0);
            const float rstd = 1.0f / sqrtf(s * (1.f / DM) + RMS_EPS);
            f32x4* o = (f32x4*)(OUT + (size_t)m * DM) + lane;
#pragma unroll
            for (int j = 0; j < 4; ++j) { const f32x4 x = {__uint_as_float(v[q][j].x << 16), __uint_as_float(v[q][j].x & 0xffff0000u), __uint_as_float(v[q][j].y << 16), __uint_as_float(v[q][j].y & 0xffff0000u)};
                o[64 * j] = x * rstd * gv[j]; } } }
    }
}

typedef short v4i16_t __attribute__((ext_vector_type(4)));
__device__ __forceinline__ s16x4 vtr(const LAS unsigned char* p) { return __builtin_bit_cast(s16x4, __builtin_amdgcn_ds_read_tr16_b64_v4i16((LAS v4i16_t*)p)); }

__device__ __forceinline__ float dil_bias(int d, float s) {
    const unsigned ud = (unsigned)d;
    const float f1 = (ud <= 128u) ? 1.f : 0.f;
    const float f2 = (((d & 3) == 0) & (ud <= 512u)) ? 1.f : 0.f;
    const float f3 = (((d & 15) == 0) & (d >= 0)) ? 1.f : 0.f;
    return s + __builtin_amdgcn_logf(f1 + f2 + f3);
}

template <int kind> __device__ __forceinline__ void attn_unit(LAS unsigned char* lds, const bf16_t* H, bf16_t* MIX, const float* ksum, int b, int h, int qb) {
    int tid_ = threadIdx.x; asm volatile("" : "+v"(tid_));
    const int tid = tid_, lane = tid & 63, r32 = lane & 31, hi = lane >> 5; const int wid = __builtin_amdgcn_readfirstlane(tid >> 6);
    const int qcol = (kind ? 1024 : 256) + h * 64, kcol = qcol + 256, vcol = qcol + 512;
    const size_t rowbase = (size_t)b * SEQ;
    const int qw0 = 256 * qb + 32 * wid, qpos = qw0 + r32;
    const int NT2 = 2 * (qb + 1);
    const int skey = 8 * wid + (lane >> 3);
    const bf16_t* kg = H + (rowbase + skey) * DIN + kcol + (((lane & 7) ^ ((skey >> 1) & 7)) * 8);
    const bf16_t* vg = H + (rowbase + skey) * DIN + vcol + (((lane & 7) ^ (((skey >> 1) & 1) << 2)) * 8);
#define STEP_TILE(t2) (((t2) < 2) ? 4 * qb + 2 * (t2) : 2 * ((t2) - 2))
#define BUF_OFF(t2) (((t2) % 3) * 32768)
#define ATT_DMA(tt) do { const size_t go_ = (size_t)(64 * STEP_TILE(tt)) * DIN; LAS unsigned char* nb_ = lds + BUF_OFF(tt) + wid * 1024; \
        __builtin_amdgcn_global_load_lds((const unsigned*)(kg + go_), (LAS unsigned*)(nb_), 16, 0, 0); \
        __builtin_amdgcn_global_load_lds((const unsigned*)(kg + go_ + (size_t)64 * DIN), (LAS unsigned*)(nb_ + 8192), 16, 0, 0); \
        __builtin_amdgcn_global_load_lds((const unsigned*)(vg + go_), (LAS unsigned*)(nb_ + 16384), 16, 0, 0); \
        __builtin_amdgcn_global_load_lds((const unsigned*)(vg + go_ + (size_t)64 * DIN), (LAS unsigned*)(nb_ + 16384 + 8192), 16, 0, 0); } while (0)
    ATT_DMA(0); ATT_DMA(1);
    bf16x8 qr[4];
    { const bf16_t* qp = H + (rowbase + qpos) * DIN + qcol + hi * 8;
#pragma unroll
      for (int d0 = 0; d0 < 4; ++d0) qr[d0] = *(const bf16x8*)(qp + 16 * d0); }
    unsigned sel = 0;
    if (kind == 0) {
        if (qb <= 3) sel = (1u << qb) - 1u;
        else {
            float g[7];
#pragma unroll
            for (int j = 0; j < 7; ++j) {
                float a = -INFINITY;
                if (j < qb) {
                    const float* k0 = ksum + (size_t)((b * 8 + j) * 2) * 256 + h * 64 + 8 * hi; const float* k1 = k0 + 256;
                    a = 0.f;
#pragma unroll
                    for (int d0 = 0; d0 < 4; ++d0) {
                        const f32x4 ka = *(const f32x4*)(k0 + 16 * d0) + *(const f32x4*)(k1 + 16 * d0), kb = *(const f32x4*)(k0 + 16 * d0 + 4) + *(const f32x4*)(k1 + 16 * d0 + 4);
                        a += bf2f(qr[d0][0]) * ka[0] + bf2f(qr[d0][1]) * ka[1] + bf2f(qr[d0][2]) * ka[2] + bf2f(qr[d0][3]) * ka[3];
                        a += bf2f(qr[d0][4]) * kb[0] + bf2f(qr[d0][5]) * kb[1] + bf2f(qr[d0][6]) * kb[2] + bf2f(qr[d0][7]) * kb[3];
                    }
                    a += __shfl_xor(a, 32);
                }
                g[j] = a;
            }
#pragma unroll
            for (int it = 0; it < 3; ++it) {
                int bi = 0; float bv = g[0];
#pragma unroll
                for (int j = 1; j < 7; ++j) if (g[j] > bv) { bv = g[j]; bi = j; }
                sel |= 1u << bi;
#pragma unroll
                for (int j = 0; j < 7; ++j) g[j] = (j == bi) ? -INFINITY : g[j];
            }
        }
    }
    int vb[2];
    { const int row = 4 * hi + ((lane & 15) >> 2), swz = ((lane >> 3) & 1) << 6;
#pragma unroll
      for (int dh = 0; dh < 2; ++dh) vb[dh] = 16384 + row * 128 + ((64 * dh + 32 * ((lane >> 4) & 1) + 8 * (lane & 3)) ^ swz); }
    const int ksw = (r32 >> 1) & 7;
    int kofs[4];
#pragma unroll
    for (int d0 = 0; d0 < 4; ++d0) kofs[d0] = r32 * 128 + 16 * ((2 * d0 + hi) ^ ksw);
    float bmid[16];
    { const int dq16 = (qpos - 4 * hi) & 15;
#pragma unroll
      for (int r = 0; r < 16; ++r) { const int c = (r & 3) + 8 * (r >> 2); const bool m3 = ((dq16 - c) & 15) == 0, m2 = ((dq16 - c) & 3) == 0;
          bmid[r] = m3 ? 1.f : (m2 ? 0.f : -INFINITY); } }
    __syncthreads();
    if (wid >= 4) __builtin_amdgcn_s_setprio(1);
    float m_run = -INFINITY, l_run = 0.f; f32x16 o[2];
#pragma unroll
    for (int r = 0; r < 16; ++r) { o[0][r] = 0.f; o[1][r] = 0.f; }
    for (int t2 = 0; t2 < NT2; ++t2) {
        const int at0 = STEP_TILE(t2);
        const LAS unsigned char* Bt = lds + BUF_OFF(t2);
        if (t2 + 2 < NT2) ATT_DMA(t2 + 2);
        const bool own = (at0 >= 4 * qb);
        const bool rowsel = ((sel >> (at0 >> 2)) & 1u) != 0u;
        bool skip[2];
#pragma unroll
        for (int s = 0; s < 2; ++s) skip[s] = (64 * (at0 + s)) > qw0 + 31;
        if (kind == 0 && !own) { if (!__any(rowsel)) { skip[0] = true; skip[1] = true; } }
        if (!(skip[0] && skip[1])) {
            f32x16 p[2][2];
#define ATT_QK(s) do { if (skip[s]) { _Pragma("unroll") for (int r = 0; r < 16; ++r) { p[s][0][r] = -INFINITY; p[s][1][r] = -INFINITY; } } else { \
                  \
                bf16x8 kf_[8]; \
                _Pragma("unroll") for (int d0 = 0; d0 < 4; ++d0) { const LAS unsigned char* kp_ = Bt + kofs[d0]; kf_[2 * d0] = *(const LAS bf16x8*)(kp_ + (s) * 8192); kf_[2 * d0 + 1] = *(const LAS bf16x8*)(kp_ + (s) * 8192 + 4096); } \
                __builtin_amdgcn_sched_barrier(0); \
                f32x16 p0, p1; \
                _Pragma("unroll") for (int r = 0; r < 16; ++r) { p0[r] = 0.f; p1[r] = 0.f; } \
                _Pragma("unroll") for (int d0 = 0; d0 < 4; ++d0) { \
                    p0 = __builtin_amdgcn_mfma_f32_32x32x16_bf16(kf_[2 * d0], qr[d0], p0, 0, 0, 0); \
                    p1 = __builtin_amdgcn_mfma_f32_32x32x16_bf16(kf_[2 * d0 + 1], qr[d0], p1, 0, 0, 0); } \
                p[s][0] = p0; p[s][1] = p1; } } while (0)
#define ATT_MASK(s) do { if (!skip[s]) { \
                const int kbase = 64 * (at0 + (s)); const int dq = qpos - kbase - 4 * hi; \
                if (kind == 0) { \
                    if (own) { _Pragma("unroll") for (int r = 0; r < 16; ++r) { const int c = (r & 3) + 8 * (r >> 2); if (c > dq) p[s][0][r] = -INFINITY; if (c + 32 > dq) p[s][1][r] = -INFINITY; } } \
                    else if (!rowsel) { _Pragma("unroll") for (int r = 0; r < 16; ++r) { p[s][0][r] = -INFINITY; p[s][1][r] = -INFINITY; } } \
                } else { \
                    const int dmin = qw0 - (kbase + 63), dmax = qw0 + 31 - kbase; \
                    if (dmin > 512) { _Pragma("unroll") for (int r = 0; r < 16; ++r) { const bool m3 = (bmid[r] == 1.f); p[s][0][r] = m3 ? p[s][0][r] : -INFINITY; p[s][1][r] = m3 ? p[s][1][r] : -INFINITY; } } \
                    else if (dmin > 128 && dmax <= 512) { _Pragma("unroll") for (int r = 0; r < 16; ++r) { p[s][0][r] += bmid[r]; p[s][1][r] += bmid[r]; } } \
                    else { _Pragma("unroll") for (int r = 0; r < 16; ++r) { const int c = (r & 3) + 8 * (r >> 2); p[s][0][r] = dil_bias(dq - c, p[s][0][r]); p[s][1][r] = dil_bias(dq - c - 32, p[s][1][r]); } } \
                } } } while (0)
            ATT_QK(0);
            __builtin_amdgcn_sched_barrier(0);
            ATT_QK(1); ATT_MASK(0);
            __builtin_amdgcn_sched_barrier(0);
            ATT_MASK(1);
#undef ATT_QK
#undef ATT_MASK
            float mx = fmaxf(fmaxf(p[0][0][0], p[0][1][0]), fmaxf(p[1][0][0], p[1][1][0]));
#pragma unroll
            for (int r = 1; r < 16; ++r) mx = fmaxf(mx, fmaxf(fmaxf(p[0][0][r], p[0][1][r]), fmaxf(p[1][0][r], p[1][1][r])));
            mx = fmaxf(mx, __shfl_xor(mx, 32));
            const float mnew = fmaxf(m_run, mx);
            const float msafe = (mnew == -INFINITY) ? 0.f : mnew;
            if (__any(mnew > m_run)) {
                const float alpha = fast_exp2(m_run - msafe);
                l_run *= alpha;
#pragma unroll
                for (int r = 0; r < 16; ++r) { o[0][r] *= alpha; o[1][r] *= alpha; }
            }
            m_run = mnew;
            float rs = 0.f;
            const LAS unsigned char* vbase[2];
            {   unsigned b0_ = (unsigned)(size_t)(Bt + vb[0]), b1_ = (unsigned)(size_t)(Bt + vb[1]); asm volatile("" : "+v"(b0_), "+v"(b1_));
                vbase[0] = (const LAS unsigned char*)(size_t)b0_; vbase[1] = (const LAS unsigned char*)(size_t)b1_; }
#pragma unroll
            for (int kk8 = 0; kk8 < 8; ++kk8) {
                const int s = kk8 >> 2, kk = kk8 & 3, hh = kk >> 1, e = 8 * (kk & 1);
                if (skip[s]) continue;
                s16x4 lo[2], hi4[2];
#pragma unroll
                for (int dh = 0; dh < 2; ++dh) { lo[dh] = vtr(vbase[dh] + s * 8192 + kk * 2048); hi4[dh] = vtr(vbase[dh] + s * 8192 + kk * 2048 + 1024); }
                float x[8];
#pragma unroll
                for (int j = 0; j < 8; ++j) { x[j] = fast_exp2(p[s][hh][e + j] - msafe); rs += x[j]; }
                const u32x4 pw = (u32x4){cvtpk(x[0], x[1]), cvtpk(x[2], x[3]), cvtpk(x[4], x[5]), cvtpk(x[6], x[7])};
#pragma unroll
                for (int dh = 0; dh < 2; ++dh) {
                    const bf16x8 vf = (bf16x8){lo[dh][0], lo[dh][1], lo[dh][2], lo[dh][3], hi4[dh][0], hi4[dh][1], hi4[dh][2], hi4[dh][3]};
                    o[dh] = __builtin_amdgcn_mfma_f32_32x32x16_bf16(vf, __builtin_bit_cast(bf16x8, pw), o[dh], 0, 0, 0);
                }
                __builtin_amdgcn_sched_barrier(0);
            }
            l_run += rs;
        }
        __syncthreads();
    }
    __builtin_amdgcn_s_setprio(0);
#undef STEP_TILE
#undef BUF_OFF
#undef ATT_DMA
    l_run += __shfl_xor(l_run, 32);
    const float inv = 1.0f / l_run;
    int tid2 = threadIdx.x; asm volatile("" : "+v"(tid2));
    bf16_t* op = MIX + ((size_t)b * SEQ + 256 * qb + 32 * (tid2 >> 6) + (tid2 & 31)) * DM + 256 + kind * 256 + h * 64 + 4 * ((tid2 >> 5) & 1);
#pragma unroll
    for (int dh = 0; dh < 2; ++dh)
#pragma unroll
        for (int rg = 0; rg < 4; ++rg) {
            u32x2 w; w.x = cvtpk(o[dh][4 * rg] * inv, o[dh][4 * rg + 1] * inv); w.y = cvtpk(o[dh][4 * rg + 2] * inv, o[dh][4 * rg + 3] * inv);
            *(u32x2*)(op + 32 * dh + 8 * rg) = w;
        }
}

__device__ __forceinline__ void pool_units(LAS unsigned char* lds, const bf16_t* H, bf16_t* MIX, const bf16_t* wpt, const float* pscale, int tile0, int ntiles) {
    int tid_ = threadIdx.x; asm volatile("" : "+v"(tid_));
    const int tid = tid_, lane = tid & 63, r32 = lane & 31, hi = lane >> 5; const int wid = __builtin_amdgcn_readfirstlane(tid >> 6);
    LAS unsigned char* ubuf = lds;
    LAS unsigned char* pbuf = lds + 79 * 512;
    u32x4 uv[5];
#define POOL_LOAD(tile_) do { const int row0_ = (tile_) * 64, tl0_ = row0_ & (SEQ - 1); \
        _Pragma("unroll") for (int it = 0; it < 5; ++it) { const int idx = tid + it * NTHREADS, r = idx >> 5, ch = idx & 31; \
            const bool ok = (idx < 79 * 32) && (tl0_ - 15 + r >= 0); \
            uv[it] = *(const u32x4*)(H + (size_t)(row0_ - 15 + (ok ? r : 15)) * DIN + ch * 8); \
            if (!ok) uv[it] = (u32x4){0u, 0u, 0u, 0u}; } } while (0)
    POOL_LOAD(tile0);
    const int gq = wid >> 1, thq = wid & 1;
    bf16x8 bfr[4][2]; float scl[2];
#pragma unroll
    for (int ks = 0; ks < 4; ++ks)
#pragma unroll
        for (int nt = 0; nt < 2; ++nt) bfr[ks][nt] = *(const bf16x8*)(wpt + (size_t)((gq * 64 + 32 * nt + r32) * 64 + 16 * ks + 8 * hi));
#pragma unroll
    for (int nt = 0; nt < 2; ++nt) scl[nt] = pscale[gq * 64 + 32 * nt + r32];
    for (int ti = 0; ti < ntiles; ++ti) {
        const int row0 = (tile0 + ti) * 64, tl0 = row0 & (SEQ - 1);
#pragma unroll
        for (int it = 0; it < 5; ++it) {
            const int idx = tid + it * NTHREADS, r = idx >> 5, ch = idx & 31;
            if (idx < 79 * 32) *(LAS u32x4*)(ubuf + r * 512 + ch * 16) = uv[it];
        }
        __syncthreads();
        if (ti + 1 < ntiles) POOL_LOAD(tile0 + ti + 1);
        {   const int t = tid >> 3, cg8 = tid & 7, g = cg8 >> 1, w = 2 << g;
            const int cnt = (tl0 + t + 1 < w) ? (tl0 + t + 1) : w; const float inv = 1.0f / (float)cnt;
#pragma unroll
            for (int chunk = 0; chunk < 4; ++chunk) {
                const int ch = cg8 * 4 + chunk;
                float s[8];
#pragma unroll
                for (int e = 0; e < 8; ++e) s[e] = 0.f;
                for (int i = 0; i < w; ++i) { const bf16x8 v = *(const LAS bf16x8*)(ubuf + (15 + t - i) * 512 + ch * 16);
#pragma unroll
                    for (int e = 0; e < 8; ++e) s[e] += bf2f(v[e]); }
                const bf16x8 self = *(const LAS bf16x8*)(ubuf + (15 + t) * 512 + ch * 16);
                u32x4 o;
                o.x = cvtpk(s[0] * inv - bf2f(self[0]), s[1] * inv - bf2f(self[1])); o.y = cvtpk(s[2] * inv - bf2f(self[2]), s[3] * inv - bf2f(self[3]));
                o.z = cvtpk(s[4] * inv - bf2f(self[4]), s[5] * inv - bf2f(self[5])); o.w = cvtpk(s[6] * inv - bf2f(self[6]), s[7] * inv - bf2f(self[7]));
                *(LAS u32x4*)(pbuf + g * 9216 + t * 144 + ((cg8 & 1) * 32 + chunk * 8) * 2) = o;
            }
        }
        __syncthreads();
        {   f32x16 acc[2];
#pragma unroll
            for (int r = 0; r < 16; ++r) { acc[0][r] = 0.f; acc[1][r] = 0.f; }
#pragma unroll
            for (int ks = 0; ks < 4; ++ks) {
                const bf16x8 a = *(const LAS bf16x8*)(pbuf + gq * 9216 + (32 * thq + r32) * 144 + (16 * ks + 8 * hi) * 2);
#pragma unroll
                for (int nt = 0; nt < 2; ++nt) acc[nt] = __builtin_amdgcn_mfma_f32_32x32x16_bf16(a, bfr[ks][nt], acc[nt], 0, 0, 0);
            }
#pragma unroll
            for (int nt = 0; nt < 2; ++nt) {
                const int col = gq * 64 + 32 * nt + r32;
#pragma unroll
                for (int r = 0; r < 16; ++r) { const int token = row0 + 32 * thq + crow(r, hi); MIX[(size_t)token * DM + col] = (bf16_t)(cvtpk(acc[nt][r] * scl[nt], 0.f) & 0xffffu); }
            }
        }
        __syncthreads();
    }
#undef POOL_LOAD
}

__device__ __forceinline__ void conv_units(LAS unsigned char* lds, const bf16_t* H, bf16_t* MIX, int layer, int tile0, int ntiles) {
    int tid_ = threadIdx.x; asm volatile("" : "+v"(tid_));
    const int tid = tid_, lane = tid & 63; const int wid = __builtin_amdgcn_readfirstlane(tid >> 6);
    LAS float* hbuf = (LAS float*)lds;
    LAS float* ybuf = (LAS float*)(lds + 62 * 1024);
    bf16x8 av[4], gv4[4];
#define CONV_LOAD(tile_) do { const int row0_ = (tile_) * 32, tl0_ = row0_ & (SEQ - 1); \
        _Pragma("unroll") for (int it = 0; it < 4; ++it) { const int idx = tid + it * NTHREADS, r = idx >> 5, ch = idx & 31; \
            const bool ok = (idx < 62 * 32) && (tl0_ - 30 + r >= 0); \
            const bf16_t* p_ = H + (size_t)(row0_ - 30 + (ok ? r : 30)) * DIN + 1792 + ch * 8; \
            av[it] = *(const bf16x8*)p_; gv4[it] = *(const bf16x8*)(p_ + 256); } } while (0)
    CONV_LOAD(tile0);
    const int c = tid & 255, th = tid >> 8;
    float wv[31];
    {   const float* cw = ldptr(lds, 10) + (size_t)layer * 31 * 256;
#pragma unroll
        for (int j = 0; j < 31; ++j) wv[j] = cw[j * 256 + c]; }
    const float bias = (ldptr(lds, 11) + (size_t)layer * 256)[c];
    const f32x4 gv = ((const f32x4*)(ldptr(lds, 12) + (size_t)layer * 256))[lane], bv = ((const f32x4*)(ldptr(lds, 13) + (size_t)layer * 256))[lane];
    for (int ti = 0; ti < ntiles; ++ti) {
        const int row0 = (tile0 + ti) * 32, tl0 = row0 & (SEQ - 1);
#pragma unroll
        for (int it = 0; it < 4; ++it) {
            const int idx = tid + it * NTHREADS, r = idx >> 5, ch = idx & 31;
            const bool ok = (idx < 62 * 32) && (tl0 - 30 + r >= 0);
            f32x4 h0 = {0.f, 0.f, 0.f, 0.f}, h1 = {0.f, 0.f, 0.f, 0.f};
            if (ok) {
#pragma unroll
                for (int e = 0; e < 4; ++e) { h0[e] = bf2f(av[it][e]) * sigmoidf_(bf2f(gv4[it][e])); h1[e] = bf2f(av[it][4 + e]) * sigmoidf_(bf2f(gv4[it][4 + e])); }
            }
            if (idx < 62 * 32) { *(LAS f32x4*)(hbuf + r * 256 + ch * 8) = h0; *(LAS f32x4*)(hbuf + r * 256 + ch * 8 + 4) = h1; }
        }
        __syncthreads();
        if (ti + 1 < ntiles) CONV_LOAD(tile0 + ti + 1);
#pragma unroll 1
        for (int q8 = 0; q8 < 2; ++q8) {
            const int tb = 16 * th + 8 * q8;
            float hv[38];
#pragma unroll
            for (int i = 0; i < 38; ++i) hv[i] = hbuf[(tb + i) * 256 + c];
            float acc[8];
#pragma unroll
            for (int tt = 0; tt < 8; ++tt) acc[tt] = bias;
#pragma unroll
            for (int j = 0; j < 31; ++j)
#pragma unroll
                for (int tt = 0; tt < 8; ++tt) acc[tt] += wv[j] * hv[tt + j];
#pragma unroll
            for (int tt = 0; tt < 8; ++tt) ybuf[(tb + tt) * 256 + c] = acc[tt];
        }
        __syncthreads();
#pragma unroll
        for (int k = 0; k < 4; ++k) {
            const int t = wid * 4 + k;
            const f32x4 y = *(const LAS f32x4*)(ybuf + t * 256 + 4 * lane);
            const float mu = wave_sum((y.x + y.y) + (y.z + y.w)) * (1.f / 256.f);
            const f32x4 d = y - mu;
            const float var = wave_sum((d.x * d.x + d.y * d.y) + (d.z * d.z + d.w * d.w)) * (1.f / 256.f);
            const float rstd = 1.0f / sqrtf(var + LN_EPS);
            f32x4 z = d * rstd * gv + bv;
#pragma unroll
            for (int e = 0; e < 4; ++e) z[e] = z[e] * sigmoidf_(z[e]);
            u32x2 w; w.x = cvtpk(z.x, z.y); w.y = cvtpk(z.z, z.w);
            *(u32x2*)(MIX + (size_t)(row0 + t) * DM + 768 + 4 * lane) = w;
        }
        __syncthreads();
    }
#undef CONV_LOAD
}

#define XB_TMO      128
#define XB_XCNT(j)  (256  + 64 * (j))
#define XB_XSUB(j)  (1280 + 64 * (j))
#define XB_XGEN(j)  (2304 + 64 * (j))
#define XB_TOP      3328
#define XB_TOPGEN   3392
#define XCD_BAR_WORDS 3456
#define XB_SPIN_CAP (1u << 18)

__device__ __forceinline__ unsigned xb_ld(unsigned* p)              { return __hip_atomic_load(p, __ATOMIC_RELAXED, __HIP_MEMORY_SCOPE_AGENT); }
__device__ __forceinline__ unsigned xb_add(unsigned* p, unsigned v) { return __hip_atomic_fetch_add(p, v, __ATOMIC_RELAXED, __HIP_MEMORY_SCOPE_AGENT); }
__device__ __forceinline__ unsigned xb_xcc_id() { return (unsigned)__builtin_amdgcn_s_getreg((3 << 11) | 20) & 0xFu; }
#define XB_SPIN(cond, bar) do { unsigned _sp = 0; while (cond) { __builtin_amdgcn_s_sleep(1); \
    if ((++_sp & 255u) == 0u) { if (xb_ld(&(bar)[XB_TMO])) break; if (_sp > XB_SPIN_CAP) { atomicAdd(&(bar)[XB_TMO], 1u); break; } } } } while (0)

struct XcdBarrier {
    unsigned* bar; unsigned x;
    volatile LAS unsigned* st;
};

__device__ __forceinline__ XcdBarrier xcd_barrier_post(unsigned* bar, volatile LAS unsigned* st) {
    XcdBarrier b; b.bar = bar; b.x = xb_xcc_id(); b.st = st;
    if (threadIdx.x == 0) (void)xb_add(&bar[XB_XCNT(b.x)], 1u);
    return b;
}
__device__ __forceinline__ void xcd_barrier_complete(unsigned* bar, unsigned x, unsigned& nloc, unsigned& nx) {
    const unsigned G = gridDim.x * gridDim.y * gridDim.z;
    unsigned sum, cnt, mine, sp = 0u;
    for (;;) {
        sum = 0u; cnt = 0u; mine = 0u;
#pragma unroll 1
        for (unsigned j = 0; j < 16; ++j) { const unsigned c = xb_ld(&bar[XB_XCNT(j)]); sum += c; cnt += (c > 0u) ? 1u : 0u; mine = (j == x) ? c : mine; }
        if (sum == G) break;
        __builtin_amdgcn_s_sleep(1);
        if ((++sp & 255u) == 0u) { if (xb_ld(&bar[XB_TMO])) break; if (sp > XB_SPIN_CAP) { atomicAdd(&bar[XB_TMO], 1u); break; } }
    }
    nloc = mine > 0u ? mine : 1u; nx = cnt > 0u ? cnt : 1u;
}

__device__ __forceinline__ void xcd_barrier(const XcdBarrier& b) {
    asm volatile("s_waitcnt vmcnt(0)" ::: "memory");
    __syncthreads();
    if (threadIdx.x == 0) {
        unsigned* bar = b.bar;
        __builtin_amdgcn_s_waitcnt(0);
        unsigned nloc = b.st[0], nx = b.st[1];
        if (nloc == 0u) { xcd_barrier_complete(bar, b.x, nloc, nx); b.st[0] = nloc; b.st[1] = nx; }
        const unsigned old = xb_add(&bar[XB_XSUB(b.x)], 1u);
        const unsigned gen = old / nloc;
        if (old + 1u == (gen + 1u) * nloc) {
            __builtin_amdgcn_fence(__ATOMIC_RELEASE, "agent");
            asm volatile("s_waitcnt vmcnt(0)" ::: "memory");
            const unsigned og = xb_add(&bar[XB_TOP], 1u);
            const unsigned tg = og / nx;
            if (og + 1u == (tg + 1u) * nx) xb_add(&bar[XB_TOPGEN], 1u);
            else XB_SPIN(xb_ld(&bar[XB_TOPGEN]) == tg, bar);
            __builtin_amdgcn_fence(__ATOMIC_ACQUIRE, "agent");
            xb_add(&bar[XB_XGEN(b.x)], 1u);
            asm volatile("s_waitcnt vmcnt(0)" ::: "memory");
        } else {
            XB_SPIN(xb_ld(&bar[XB_XGEN(b.x)]) == gen, bar);
            __builtin_amdgcn_fence(__ATOMIC_ACQUIRE, "agent");
            asm volatile("s_waitcnt vmcnt(0)" ::: "memory");
        }
    }
    __syncthreads();
}

constexpr int N_PHASES = 2 + 7 * DEPTH;
#ifndef REP_MIX
#define REP_MIX 1
#endif
#ifndef REP_NORM
#define REP_NORM 1
#endif
#ifndef REP_G1
#define REP_G1 1
#endif
#ifndef REP_G3
#define REP_G3 1
#endif
#ifndef REP_PRO
#define REP_PRO 1
#endif
#ifndef REP_SYNC
#define REP_SYNC 1
#endif
__global__ void __launch_bounds__(NTHREADS, 2) fwd_megakernel(Args A) {
    extern __shared__ __attribute__((aligned(16))) unsigned char lds_raw[];
    LAS unsigned char* lds = (LAS unsigned char*)lds_raw;
    cg::grid_group grid = cg::this_grid();
    int tid_ = threadIdx.x; asm volatile("" : "+v"(tid_));
    const int tid = tid_, lane = tid & 63; const int wave = __builtin_amdgcn_readfirstlane(tid >> 6);
    const int G = gridDim.x, bx = blockIdx.x;
    const int gw = bx * NWAVES + wave, NGW = G * NWAVES;
    unsigned char* ws = A.ws;
    bf16_t* XN = (bf16_t*)(ws + WS_XN); bf16_t* ACT = (bf16_t*)(ws + WS_ACT); bf16_t* MIXB = (bf16_t*)(ws + WS_MIX); float* SSQ = (float*)(ws + WS_SSQ);
    float* X = A.out;
    int ph0 = 1;
    unsigned* barw = (unsigned*)(ws + WS_BAR);
    volatile LAS unsigned* bst = (volatile LAS unsigned*)(lds + 131072 + 512);
    if (tid == 0) { bst[0] = 0u; bst[1] = 0u;
#pragma unroll
        for (int i = 0; i < 20; ++i) ((LAS unsigned long long*)(lds + PTR_OFF))[i] = (unsigned long long)A.in[i]; }
    __syncthreads();
    if (bx == 0) { for (int i = tid; i < XCD_BAR_WORDS; i += NTHREADS) barw[i] = 0u; }
    for (int rep = 0; rep < REP_PRO; ++rep) prologue(A, lds, gw, NGW, wave, lane);
    grid.sync();
    XcdBarrier xbar = xcd_barrier_post(barw, bst);
    for (int ph = ph0; ph < N_PHASES - 1; ++ph) {
        if (ph > ph0) { for (int rep = 0; rep < REP_SYNC; ++rep) xcd_barrier(xbar); }
        const int l = (ph - 1) / 7, k = (ph - 1) % 7;
        unsigned char* wl = ws + WS_W + (size_t)l * W_LAYER;
        if (k == 0 || k == 5) {
            pg8::Gemm gm{XN, (const bf16_t*)(wl + (k == 0 ? WO_GU1 : WO_GU2)), M_TOK, 2 * DFF, DM};
            pg8::StaticOrder S; S.init(M_TOK, 2 * DFF, G, bx);
            pg8::EpiSwiGLU E{ws, lds};
            pg8::rstd_cache_fill(lds, SSQ, S);
            for (int rep = 0; rep < REP_G1; ++rep) pg8::gemm_phase<pg8::EpiSwiGLU, pg8::StaticOrder, true, true>(lds, gm, S, E);
        } else if (k == 1 || k == 4 || k == 6) {
            const bf16_t* Am = (k == 4) ? MIXB : ACT;
            const bf16_t* Bm = (const bf16_t*)(wl + (k == 1 ? WO_D1 : k == 4 ? WO_OUT : WO_D2));
            pg8::Gemm gm{Am, Bm, M_TOK, DM, (k == 4) ? DM : DFF};
            pg8::StaticOrder S; S.init(M_TOK, DM, G, bx);
            pg8::EpiResid E{X, ws, 0};
#ifndef REP_G2
#define REP_G2 1
#endif
            for (int rep = 0; rep < REP_G2; ++rep) { E.full = ((k == 4) ? 1 : 0) | ((rep < REP_G2 - 1) ? 2 : 0) ; pg8::gemm_phase<pg8::EpiResid, pg8::StaticOrder, true, true>(lds, gm, S, E); }
        } else if (k == 2) {
            pg8::Gemm gm{XN, (const bf16_t*)(wl + WO_IN), M_TOK, DIN, DM};
            pg8::StaticOrder S; S.init(M_TOK, DIN, G, bx);
            pg8::EpiH E{ws, l, lds};
            pg8::rstd_cache_fill(lds, SSQ, S);
            for (int rep = 0; rep < REP_G3; ++rep) pg8::gemm_phase<pg8::EpiH, pg8::StaticOrder, true, true>(lds, gm, S, E);
        } else {
            const bf16_t* Hm = ACT; bf16_t* MIX = MIXB;
            const float* ksum = (const float*)(ws + WS_KSUM) + (size_t)l * 65536;
            for (int rep = 0; rep < REP_MIX; ++rep)
            for (int u0 = bx; u0 < 2560; u0 += G) {
                int u = u0;
                if (G == 256) { const int c = u0 & 255, rnd = u0 >> 8, x = c & 7, y = c >> 3;
                    if (u0 < 1024) u = u0; else if (u0 < 1536) { if (rnd != 4) continue; u = 1024 + x * 64 + 2 * y; } else { if (rnd != 6) continue; u = 1536 + x * 128 + 4 * y; } }
                if (u < 1024) {
                    const int round = u >> 8, c = u & 255;
                    int half, rest_kind, b, h;
                    if (G == 256) { const int x = c & 7, y = c >> 3; half = y & 1; b = 2 * x + ((y >> 1) & 1); h = (y >> 2) & 3; rest_kind = (y >> 4) & 1; }
                    else { half = c & 1; const int rest = c >> 1; rest_kind = rest >> 6; b = (rest >> 2) & 15; h = rest & 3; }
                    const int qb = (round == 0) ? (half ? 6 : 7) : (round == 1) ? (half ? 1 : 0) : (round == 2) ? (half ? 4 : 5) : (half ? 3 : 2);
                    const int kind = (rest_kind + (round >> 1)) & 1;
#ifndef REP_ATTN
#define REP_ATTN 1
#endif
                    for (int ra = 0; ra < REP_ATTN; ++ra) { if (kind) attn_unit<1>(lds, Hm, MIX, ksum, b, h, qb); else attn_unit<0>(lds, Hm, MIX, ksum, b, h, qb); }
                } else if (u < 1536) {
                    pool_units(lds, Hm, MIX, (const bf16_t*)(ws + WS_WPT) + (size_t)l * 16384, ldptr(lds, 9) + (size_t)l * 256, u - 1024, (G == 256) ? 2 : 1);
                } else {
                    conv_units(lds, Hm, MIX, l, u - 1536, (G == 256) ? 4 : 1);
                }
            }
        }
    }
    xcd_barrier(xbar);
    {   int t3 = threadIdx.x; asm volatile("" : "+v"(t3));
        const int w3 = __builtin_amdgcn_readfirstlane(t3 >> 6);
        const int c3 = blockIdx.x, g3 = gridDim.x;
        const int m0 = (g3 == 256) ? 4096 * (c3 & 7) + (c3 >> 3) * 8 + w3 : c3 * NWAVES + w3;
        const int ms = (g3 == 256) ? 256 : g3 * NWAVES;
        const int me = (g3 == 256) ? 4096 * (c3 & 7) + 4096 : M_TOK;
        norm_rows_final(XN, SSQ, ldptr(lds, 19), X, m0, ms, me, t3 & 63); }
}

#ifndef MK_MULTI
#define MK_MULTI 0
#endif
extern "C" void kernel_launch(void* const* d_in, const int* in_sizes, int n_in, void* d_out, int out_size, void* d_ws, size_t ws_size, hipStream_t stream) {
    static int grid = 0;
    if (grid == 0) {
        if (n_in != 20 || in_sizes[0] != M_TOK * DM || out_size != M_TOK * DM || ws_size < WS_END) { fprintf(stderr, "kernel_launch: unexpected shapes (n_in %d, in0 %d, out %d, ws %zu)\n", n_in, n_in > 0 ? in_sizes[0] : -1, out_size, ws_size); grid = -1; return; }
        int dev = 0, cus = 0, per_cu = 0;
        if (hipGetDevice(&dev) != hipSuccess || hipDeviceGetAttribute(&cus, hipDeviceAttributeMultiprocessorCount, dev) != hipSuccess) { grid = -1; return; }
        if (hipFuncSetAttribute((const void*)fwd_megakernel, hipFuncAttributeMaxDynamicSharedMemorySize, LDS_BYTES) != hipSuccess) { fprintf(stderr, "kernel_launch: hipFuncSetAttribute failed\n"); grid = -1; return; }
        if (hipOccupancyMaxActiveBlocksPerMultiprocessor(&per_cu, (const void*)fwd_megakernel, NTHREADS, LDS_BYTES) != hipSuccess || per_cu < 1) { fprintf(stderr, "kernel_launch: occupancy query says %d\n", per_cu); per_cu = 1; }
        (void)hipGetLastError();
        grid = cus * per_cu;
    }
    if (grid < 0) return;
    Args a{};
    for (int i = 0; i < 20; ++i) a.in[i] = (const float*)d_in[i];
    a.out = (float*)d_out; a.ws = (unsigned char*)d_ws;
#if MK_MULTI
    for (int ph = 0; ph < N_PHASES; ++ph) { a.ph_lo = ph; a.ph_hi = ph + 1; hipLaunchKernelGGL(fwd_megakernel, dim3(grid), dim3(NTHREADS), LDS_BYTES, stream, a); }
#else
    a.ph_lo = 0; a.ph_hi = N_PHASES;
    void* args[] = {&a};
    hipError_t e = hipLaunchCooperativeKernel((const void*)fwd_megakernel, dim3(grid), dim3(NTHREADS), args, LDS_BYTES, stream);
    if (e != hipSuccess) fprintf(stderr, "cooperative launch failed: %s (grid %d)\n", hipGetErrorString(e), grid);
#endif
}
```

```cpp
#include <hip/hip_runtime.h>
#include <hip/hip_cooperative_groups.h>
#include <cstdio>
#include <cstdint>
namespace cg = cooperative_groups;
namespace pg8 {
#define PG8_LAS __attribute__((address_space(3)))
typedef unsigned short bf16_t;
typedef short bf16x8 __attribute__((ext_vector_type(8)));
typedef float f32x4 __attribute__((ext_vector_type(4)));
typedef unsigned u32x4 __attribute__((ext_vector_type(4)));
constexpr int BM = 256, BK = 64, HALF = 128, HTB = HALF * BK * 2  , STAGE_BYTES = 8 * HTB, NXCD = 8, WGM = 8;

__host__ __device__ __forceinline__ int lds_byte(int r, int c) { const int st = (r >> 4) * 2 + (c >> 5), rr = r & 15, cc = c & 31, ob = rr * 64 + cc * 2; return st * 1024 + (ob ^ (((ob >> 9) & 1) << 5)); }
__host__ __device__ __forceinline__ void stage_rc(int b, int& R, int& C) { const int st = b / 1024, sb = b % 1024, swz = sb ^ (((sb >> 9) & 1) << 5); R = (st >> 1) * 16 + swz / 64; C = (st & 1) * 32 + (swz % 64) / 2; }
__host__ __device__ __forceinline__ int perm32(int rho) { const int n = rho >> 4, i = rho & 15; return 8 * (i >> 2) + 4 * n + (i & 3); }

struct Unit { int pm, pn; };
struct Gemm { const bf16_t* A; const bf16_t* Bt; int M, N, K; };

struct StaticOrder {
    int nM, nN, nwg, G, c, rev;
    __host__ __device__ void init(int M, int N, int G_, int c_, int rev_ = 0) { nM = M / BM; nN = N / BM; nwg = nM * nN; G = G_; c = c_; rev = rev_; }
    __host__ __device__ bool next(int i, Unit& u) const {
        const long L = (long)i * G + c; if (L >= nwg) return false;
        int wgid = (int)L; { const int q = nwg / NXCD, r = nwg % NXCD, xcd = wgid % NXCD, off = wgid / NXCD; wgid = (xcd < r ? xcd * (q + 1) : r * (q + 1) + (xcd - r) * q) + off; }
        const int nig = WGM * nN, gid = wgid / nig, fm = gid * WGM, gsz = (nM - fm) < WGM ? (nM - fm) : WGM;
        u.pm = fm + ((wgid % nig) % gsz); u.pn = (wgid % nig) / gsz; if (rev) u.pm = nM - 1 - u.pm; return true;
    }
    __device__ __forceinline__ void a_ready(const Unit&) const {}
    __device__ __forceinline__ void done(const Unit&) const {}
};
__device__ __forceinline__ unsigned cvt_pk_bf16(float lo, float hi) { unsigned r; asm volatile("v_cvt_pk_bf16_f32 %0, %1, %2" : "=v"(r) : "v"(lo), "v"(hi)); return r; }
typedef float f32x2 __attribute__((ext_vector_type(2)));
template <class Epi, class Sched, bool ALIGN_EPI = false, bool SP2 = false>
__device__ __forceinline__ void gemm_phase(PG8_LAS unsigned char* lds, const Gemm g, const Sched& S, const Epi& E) {
    int tid_ = threadIdx.x; asm volatile("" : "+v"(tid_));
    const int tid = tid_, wid = __builtin_amdgcn_readfirstlane(tid >> 6), lane = tid & 63, wr = wid >> 2, wc = wid & 3, fr = lane & 15, fq = lane >> 4;
    const int K = g.K, nt = K / BK;
    unsigned voffA[2], voffB[2];
#pragma unroll
    for (int i = 0; i < 2; ++i) { int R, C; stage_rc(tid * 16 + i * 8192, R, C); const int Rb = Epi::PERM ? ((R & ~31) + perm32(R & 31)) : R;
        voffA[i] = (unsigned)(R * K + C) * 2u; voffB[i] = (unsigned)(Rb * K + C) * 2u; }
    const size_t kstep = (size_t)(BK * 2);
    const size_t hstep = (size_t)HALF * K * 2;
    const size_t tstep = 2 * hstep;
    const unsigned ldsw = (unsigned)wid * 1024u;
    const int aoff = lds_byte(wr * 64 + fr, fq * 8), boff = lds_byte(wc * 32 + fr, fq * 8);
#define PG8_SA(b, h) (((b) * 2 + (h)) * HTB)
#define PG8_SB(b, h) ((4 + (b) * 2 + (h)) * HTB)
#define PG8_STAGE(bufoff, gbase, voff) do { _Pragma("unroll") for (int _i = 0; _i < 2; ++_i) \
        __builtin_amdgcn_global_load_lds((const unsigned*)((const char*)(gbase) + (voff)[_i]), (PG8_LAS unsigned*)(lds + (bufoff) + ldsw + _i * 8192), 16, 0, 0); } while (0)
#define PG8_LDA(dst, b, h) do { _Pragma("unroll") for (int m = 0; m < 4; ++m) _Pragma("unroll") for (int k = 0; k < 2; ++k) dst[m][k] = *(const PG8_LAS bf16x8*)(lds + PG8_SA(b, h) + aoff + m * 2048 + k * 1024); } while (0)
#define PG8_LDB(dst, b, h) do { _Pragma("unroll") for (int n = 0; n < 2; ++n) _Pragma("unroll") for (int k = 0; k < 2; ++k) dst[n][k] = *(const PG8_LAS bf16x8*)(lds + PG8_SB(b, h) + boff + n * 2048 + k * 1024); } while (0)
#define PG8_MMA(ai, bj, At, Bt) do { __builtin_amdgcn_s_setprio(1); _Pragma("unroll") for (int m = 0; m < 4; ++m) _Pragma("unroll") for (int n = 0; n < 2; ++n) _Pragma("unroll") for (int k = 0; k < 2; ++k) \
        acc[ai][bj][m][n] = __builtin_amdgcn_mfma_f32_16x16x32_bf16(Bt[n][k], At[m][k], acc[ai][bj][m][n], 0, 0, 0); __builtin_amdgcn_s_setprio(0); } while (0)
#define PG8_WAIT_V(n) asm volatile("s_waitcnt vmcnt(" #n ")" ::: "memory")
#define PG8_WAIT_L(n) asm volatile("s_waitcnt lgkmcnt(" #n ")" ::: "memory")
#define PG8_BAR __builtin_amdgcn_s_barrier()
#define PG8_SCHED __builtin_amdgcn_sched_barrier(0)
    Unit cur, nxt; int ui = 0;
    if (!S.next(0, cur)) return;
    f32x4 acc[2][2][4][2];
#pragma unroll
    for (int a = 0; a < 2; ++a)
#pragma unroll
        for (int b = 0; b < 2; ++b)
#pragma unroll
            for (int m = 0; m < 4; ++m)
#pragma unroll
                for (int n = 0; n < 2; ++n) acc[a][b][m][n] = (f32x4){0.f, 0.f, 0.f, 0.f};
    bf16x8 At[4][2], B0[2][2], B1[2][2];
    const char* cA = (const char*)g.A + (size_t)cur.pm * tstep; const char* cB = (const char*)g.Bt + (size_t)cur.pn * tstep;
    S.a_ready(cur);
    if constexpr (SP2) {
        PG8_STAGE(PG8_SB(0, 0), cB, voffB); PG8_STAGE(PG8_SB(0, 1), cB + hstep, voffB); PG8_STAGE(PG8_SA(0, 0), cA, voffA); PG8_STAGE(PG8_SA(0, 1), cA + hstep, voffA);
        if (wr == 1) PG8_BAR;
        PG8_WAIT_V(2); PG8_BAR;
        PG8_STAGE(PG8_SB(1, 0), cB + kstep, voffB); PG8_STAGE(PG8_SA(1, 0), cA + kstep, voffA); PG8_STAGE(PG8_SB(1, 1), cB + hstep + kstep, voffB);
        PG8_WAIT_V(6); PG8_BAR;
    } else {
        PG8_STAGE(PG8_SB(0, 0), cB, voffB); PG8_STAGE(PG8_SA(0, 0), cA, voffA); PG8_STAGE(PG8_SB(0, 1), cB + hstep, voffB); PG8_STAGE(PG8_SA(0, 1), cA + hstep, voffA);
        if (wr == 1) PG8_BAR;
        PG8_WAIT_V(4); PG8_BAR;
        PG8_STAGE(PG8_SB(1, 0), cB + kstep, voffB); PG8_STAGE(PG8_SA(1, 0), cA + kstep, voffA); PG8_STAGE(PG8_SB(1, 1), cB + hstep + kstep, voffB);
        PG8_WAIT_V(6); PG8_BAR;
    }
    for (;;) {
        const bool has_next = S.next(ui + 1, nxt);
        const char* nA = has_next ? (const char*)g.A + (size_t)nxt.pm * tstep : cA; const char* nB = has_next ? (const char*)g.Bt + (size_t)nxt.pn * tstep : cB;
        for (int t = 0; t < nt; t += 2) {
            const bool last = (t == nt - 2);
            const char* a1 = cA + (size_t)(t + 1) * kstep;
            const char* a2 = last ? nA : cA + (size_t)(t + 2) * kstep; const char* b2 = last ? nB : cB + (size_t)(t + 2) * kstep;
            const char* a3 = a2 + kstep; const char* b3 = b2 + kstep;
            if (last && has_next) S.a_ready(nxt);
            if constexpr (SP2) {
            PG8_LDB(B0, 0, 0); PG8_LDB(B1, 0, 1); PG8_SCHED; PG8_LDA(At, 0, 0); PG8_STAGE(PG8_SA(1, 1), a1 + hstep, voffA);
            PG8_WAIT_V(8); PG8_WAIT_L(0); PG8_BAR; PG8_MMA(0, 0, At, B0); PG8_MMA(0, 1, At, B1); PG8_BAR; PG8_SCHED;
            PG8_LDA(At, 0, 1); PG8_STAGE(PG8_SB(0, 0), b2, voffB); PG8_STAGE(PG8_SB(0, 1), b2 + hstep, voffB); PG8_STAGE(PG8_SA(0, 0), a2, voffA);
            PG8_WAIT_V(8); PG8_WAIT_L(0); PG8_BAR; PG8_MMA(1, 0, At, B0); PG8_MMA(1, 1, At, B1); PG8_BAR; PG8_SCHED;
            PG8_LDB(B0, 1, 0); PG8_LDB(B1, 1, 1); PG8_SCHED; PG8_LDA(At, 1, 0); PG8_STAGE(PG8_SA(0, 1), a2 + hstep, voffA);
            PG8_WAIT_V(8); PG8_WAIT_L(0); PG8_BAR; PG8_MMA(0, 0, At, B0); PG8_MMA(0, 1, At, B1); PG8_BAR; PG8_SCHED;
            PG8_LDA(At, 1, 1); PG8_STAGE(PG8_SB(1, 0), b3, voffB); PG8_STAGE(PG8_SB(1, 1), b3 + hstep, voffB); PG8_STAGE(PG8_SA(1, 0), a3, voffA);
            PG8_WAIT_V(8); PG8_WAIT_L(0); PG8_BAR; PG8_MMA(1, 0, At, B0); PG8_MMA(1, 1, At, B1); PG8_BAR; PG8_SCHED;
            } else {
            PG8_LDB(B0, 0, 0); PG8_SCHED; PG8_LDA(At, 0, 0); PG8_STAGE(PG8_SA(1, 1), a1 + hstep, voffA);
            PG8_WAIT_L(8); PG8_BAR; PG8_WAIT_L(0); PG8_MMA(0, 0, At, B0); PG8_BAR; PG8_SCHED;
            PG8_LDB(B1, 0, 1); PG8_STAGE(PG8_SB(0, 0), b2, voffB);
            PG8_BAR; PG8_WAIT_L(0); PG8_MMA(0, 1, At, B1); PG8_BAR;
            PG8_LDA(At, 0, 1); PG8_STAGE(PG8_SA(0, 0), a2, voffA);
            PG8_BAR; PG8_WAIT_L(0); PG8_MMA(1, 0, At, B0); PG8_BAR; PG8_SCHED;
            PG8_STAGE(PG8_SB(0, 1), b2 + hstep, voffB);
            PG8_WAIT_V(6); PG8_BAR; PG8_MMA(1, 1, At, B1); PG8_BAR;
            PG8_LDB(B0, 1, 0); PG8_SCHED; PG8_LDA(At, 1, 0); PG8_STAGE(PG8_SA(0, 1), a2 + hstep, voffA);
            PG8_WAIT_L(8); PG8_BAR; PG8_WAIT_L(0); PG8_MMA(0, 0, At, B0); PG8_BAR; PG8_SCHED;
            PG8_LDB(B1, 1, 1); PG8_STAGE(PG8_SB(1, 0), b3, voffB);
            PG8_BAR; PG8_WAIT_L(0); PG8_MMA(0, 1, At, B1); PG8_BAR;
            PG8_LDA(At, 1, 1); PG8_STAGE(PG8_SA(1, 0), a3, voffA);
            PG8_BAR; PG8_WAIT_L(0); PG8_MMA(1, 0, At, B0); PG8_BAR; PG8_SCHED;
            PG8_STAGE(PG8_SB(1, 1), b3 + hstep, voffB);
            PG8_WAIT_V(6); PG8_BAR; PG8_MMA(1, 1, At, B1); PG8_BAR;
            }
        }
        if constexpr (ALIGN_EPI) { if (wr == 0) PG8_BAR; }
        if constexpr (!Epi::AFTER_DRAIN) { E(acc, cur, ui, wr, wc, fr, fq); S.done(cur); }
        if (!has_next) break;
#pragma unroll
        for (int a = 0; a < 2; ++a)
#pragma unroll
            for (int b = 0; b < 2; ++b)
#pragma unroll
                for (int m = 0; m < 4; ++m)
#pragma unroll
                    for (int n = 0; n < 2; ++n) acc[a][b][m][n] = (f32x4){0.f, 0.f, 0.f, 0.f};
        cur = nxt; cA = nA; cB = nB; ++ui;
        if constexpr (ALIGN_EPI) { if (wr == 1) PG8_BAR; }
    }
    PG8_WAIT_V(0);
    if constexpr (!ALIGN_EPI) { if (wr == 0) PG8_BAR; }
    PG8_BAR;
    if constexpr (Epi::AFTER_DRAIN) { E.fused(acc, cur, wr, wc, fr, fq, lds, wid, lane); S.done(cur); }
#undef PG8_SA
#undef PG8_SB
#undef PG8_STAGE
#undef PG8_LDA
#undef PG8_LDB
#undef PG8_MMA
#undef PG8_WAIT_V
#undef PG8_WAIT_L
#undef PG8_BAR
#undef PG8_SCHED
}
}

#define LAS __attribute__((address_space(3)))
typedef unsigned short bf16_t;
typedef short bf16x8 __attribute__((ext_vector_type(8)));
typedef short s16x4 __attribute__((ext_vector_type(4)));
typedef float f32x4 __attribute__((ext_vector_type(4)));
typedef float f32x16 __attribute__((ext_vector_type(16)));
typedef unsigned u32x4 __attribute__((ext_vector_type(4)));
typedef unsigned u32x2 __attribute__((ext_vector_type(2)));

constexpr int BATCH = 16, SEQ = 2048, DM = 1024, DFF = 2816, DIN = 2304, DEPTH = 2, M_TOK = BATCH * SEQ;
constexpr int NWAVES = 8, NTHREADS = 512;
constexpr int LDS_BYTES = 147456;
constexpr float C2 = 0.125f * 1.4426950408889634f;
constexpr float RMS_EPS = 1e-6f, LN_EPS = 1e-5f;
constexpr size_t MiB = 1u << 20;
constexpr size_t WS_BAR = 65536;
constexpr size_t WS_ROPE = 1 * MiB;
constexpr size_t WS_KSUM = 3 * MiB;
constexpr size_t WS_WPT = 3 * MiB + 512 * 1024;
constexpr size_t WS_W = 4 * MiB;
constexpr size_t W_GU = (size_t)2 * DFF * DM * 2, W_D = (size_t)DM * DFF * 2, W_IN = (size_t)DIN * DM * 2, W_OUT = (size_t)DM * DM * 2;
constexpr size_t WO_GU1 = 0, WO_D1 = W_GU, WO_IN = WO_D1 + W_D, WO_OUT = WO_IN + W_IN, WO_GU2 = WO_OUT + W_OUT, WO_D2 = WO_GU2 + W_GU, W_LAYER = WO_D2 + W_D;
constexpr size_t WS_XN = 84 * MiB;
constexpr size_t WS_ACT = 148 * MiB;
constexpr size_t WS_MIX = 324 * MiB;
constexpr size_t WS_SSQ = 388 * MiB;
constexpr size_t WS_END = 390 * MiB;
static_assert(WS_W + DEPTH * W_LAYER <= WS_XN, "weights fit");
static_assert(WS_XN + (size_t)M_TOK * DM * 2 <= WS_ACT && WS_ACT + (size_t)M_TOK * DFF * 2 <= WS_MIX, "ws map");

__device__ __forceinline__ float bf2f(short h) { return __uint_as_float(((unsigned)(unsigned short)h) << 16); }
typedef float f32x2_t __attribute__((ext_vector_type(2))); typedef __bf16 bf16x2_t __attribute__((ext_vector_type(2)));
__device__ __forceinline__ unsigned cvtpk(float lo, float hi) { f32x2_t v = {lo, hi}; bf16x2_t b = __builtin_convertvector(v, bf16x2_t); return __builtin_bit_cast(unsigned, b); }
__device__ __forceinline__ float wave_sum(float v) {
#pragma unroll
    for (int o = 1; o < 64; o <<= 1) v += __shfl_xor(v, o);
    return v;
}
__device__ __forceinline__ float fast_exp2(float x) { return __builtin_amdgcn_exp2f(x); }
__device__ __forceinline__ float sigmoidf_(float x) { return __builtin_amdgcn_rcpf(1.f + fast_exp2(-1.4426950408889634f * x)); }
__device__ __forceinline__ int crow(int r, int hi) { return (r & 3) + 8 * (r >> 2) + 4 * hi; }

namespace pg8 {
constexpr int RC_OFF = 131072 + 2048, RC_UNITS = 12;
__device__ __forceinline__ float row_rstd(const PG8_LAS unsigned char* lds, int ui, int rloc) { return *(const PG8_LAS float*)(lds + RC_OFF + ((ui < RC_UNITS ? ui : 0) * 256 + rloc) * 4); }
__device__ __forceinline__ float row_rstd_global(const float* ssq, int row, int fq) {
    const f32x4 q = *(const f32x4*)(ssq + (size_t)row * 16 + 4 * fq);
    float s = (q[0] + q[1]) + (q[2] + q[3]);
    s += __shfl_xor(s, 16); s += __shfl_xor(s, 32);
    return 1.0f / sqrtf(s * (1.f / DM) + RMS_EPS);
}
template <class Sched> __device__ __forceinline__ void rstd_cache_fill(PG8_LAS unsigned char* lds, const float* ssq, const Sched& S) {
    int tid_ = threadIdx.x; asm volatile("" : "+v"(tid_));
    const int r = tid_ >> 1, h = tid_ & 1;
    PG8_LAS int* pml = (PG8_LAS int*)(lds + RC_OFF - 64);
    if (tid_ < RC_UNITS) { Unit u; u.pm = 0; u.pn = 0; const bool ok = S.next(tid_, u); pml[tid_] = ok ? u.pm : -1; }
    __syncthreads();
    f32x4 qa[RC_UNITS], qb[RC_UNITS]; int pmv[RC_UNITS];
#pragma unroll
    for (int i = 0; i < RC_UNITS; ++i) {
        pmv[i] = pml[i];
        const float* q = ssq + (size_t)((pmv[i] < 0 ? 0 : pmv[i]) * BM + r) * 16 + 8 * h;
        qa[i] = *(const f32x4*)q; qb[i] = *(const f32x4*)(q + 4);
    }
#pragma unroll
    for (int i = 0; i < RC_UNITS; ++i) {
        float s = ((qa[i][0] + qa[i][1]) + (qa[i][2] + qa[i][3])) + ((qb[i][0] + qb[i][1]) + (qb[i][2] + qb[i][3]));
        s += __shfl_xor(s, 1);
        if (h == 0 && pmv[i] >= 0) *(PG8_LAS float*)(lds + RC_OFF + (i * 256 + r) * 4) = 1.0f / sqrtf(s * (1.f / DM) + RMS_EPS);
    }
    __syncthreads();
}
struct EpiSwiGLU {
    static constexpr bool PERM = true, AFTER_DRAIN = false;
    unsigned char* ws; PG8_LAS unsigned char* lds;
    __device__ __forceinline__ void operator()(f32x4 (&acc)[2][2][4][2], const Unit& u, int ui, int wr, int wc, int fr, int fq) const {
        bf16_t* const O = (bf16_t*)(ws + WS_ACT); constexpr int ldc = DFF;
        const int row0 = u.pm * BM + wr * 64 + fr, col0 = u.pn * HALF + wc * 32 + 8 * fq;
        float rsv[2][4];
#pragma unroll
        for (int ai = 0; ai < 2; ++ai)
#pragma unroll
            for (int m = 0; m < 4; ++m) rsv[ai][m] = row_rstd(lds, ui, wr * 64 + fr + ai * HALF + m * 16);
        if (ui >= RC_UNITS) {
#pragma unroll
            for (int ai = 0; ai < 2; ++ai)
#pragma unroll
                for (int m = 0; m < 4; ++m) rsv[ai][m] = row_rstd_global((const float*)(ws + WS_SSQ), u.pm * BM + wr * 64 + fr + ai * HALF + m * 16, fq);
        }
#pragma unroll
        for (int ai = 0; ai < 2; ++ai)
#pragma unroll
            for (int m = 0; m < 4; ++m) {
                bf16_t* rowp = O + (size_t)(row0 + ai * HALF + m * 16) * ldc + col0;
                const float rs = rsv[ai][m];
                float v[8];
#pragma unroll
                for (int n = 0; n < 2; ++n)
#pragma unroll
                    for (int i = 0; i < 4; ++i) { const float g = acc[ai][0][m][n][i] * rs, up = acc[ai][1][m][n][i] * rs; v[n * 4 + i] = g * sigmoidf_(g) * up; }
                u32x4 w; w.x = cvtpk(v[0], v[1]); w.y = cvtpk(v[2], v[3]); w.z = cvtpk(v[4], v[5]); w.w = cvtpk(v[6], v[7]);
                *(u32x4*)rowp = w;
            }
    }
};
struct EpiResid {
    static constexpr bool PERM = false, AFTER_DRAIN = false;
    float* out; unsigned char* ws; int full;
    __device__ __forceinline__ void operator()(f32x4 (&acc)[2][2][4][2], const Unit& u, int ui, int wr, int wc, int fr, int fq) const {
        bf16_t* const xb = (bf16_t*)(ws + WS_XN); float* const ssq = (float*)(ws + WS_SSQ); constexpr int ldc = DM; const float alpha = (full & 2) ? 0.0f : ((full & 1) ? 1.0f : 0.5f);
        const bool wf32 = (full & 4) != 0;
        const int col0 = u.pn * BM + wc * 32 + 4 * fq;
        const int rowb = u.pm * BM + wr * 64 + fr;
        constexpr int RB = 4, NB = 8 / RB;
        u32x2 t[RB][2][2];
#pragma unroll
        for (int j = 0; j < RB; ++j)
#pragma unroll
            for (int bj = 0; bj < 2; ++bj)
#pragma unroll
                for (int n = 0; n < 2; ++n) t[j][bj][n] = *(const u32x2*)(xb + (size_t)(rowb + (j >> 2) * HALF + (j & 3) * 16) * ldc + col0 + bj * HALF + n * 16);
#pragma unroll
        for (int b = 0; b < NB; ++b) {
#pragma unroll
            for (int j = 0; j < RB; ++j) { const int it = b * RB + j, ai = it >> 2, m = it & 3;
#pragma unroll
                for (int bj = 0; bj < 2; ++bj)
#pragma unroll
                    for (int n = 0; n < 2; ++n) { const u32x2 r = t[j][bj][n];
                        const f32x4 bs = {__uint_as_float(r.x << 16), __uint_as_float(r.x & 0xffff0000u), __uint_as_float(r.y << 16), __uint_as_float(r.y & 0xffff0000u)};
                        acc[ai][bj][m][n] = bs + acc[ai][bj][m][n] * alpha; } }
            if (b + 1 < NB) {
#pragma unroll
                for (int j = 0; j < RB; ++j) { const int it = (b + 1) * RB + j;
#pragma unroll
                    for (int bj = 0; bj < 2; ++bj)
#pragma unroll
                        for (int n = 0; n < 2; ++n) t[j][bj][n] = *(const u32x2*)(xb + (size_t)(rowb + (it >> 2) * HALF + (it & 3) * 16) * ldc + col0 + bj * HALF + n * 16); }
            }
#pragma unroll
            for (int j = 0; j < RB; ++j) { const int it = b * RB + j, ai = it >> 2, m = it & 3;
                const int row = rowb + ai * HALF + m * 16;
                const size_t off = (size_t)row * ldc + col0;
                float ss = 0.f;
#pragma unroll
                for (int bj = 0; bj < 2; ++bj)
#pragma unroll
                    for (int n = 0; n < 2; ++n) {
                        const f32x4 v = acc[ai][bj][m][n];
                        if (wf32) *(f32x4*)(out + off + bj * HALF + n * 16) = v;
                        u32x2 w; w.x = cvtpk(v[0], v[1]); w.y = cvtpk(v[2], v[3]);
                        *(u32x2*)(xb + off + bj * HALF + n * 16) = w;
                        ss += (v[0] * v[0] + v[1] * v[1]) + (v[2] * v[2] + v[3] * v[3]);
                    }
                ss += __shfl_xor(ss, 16); ss += __shfl_xor(ss, 32);
                if (fq == 0) ssq[(size_t)row * 16 + 4 * u.pn + wc] = ss;
            }
        }
    }
};
struct EpiH {
    static constexpr bool PERM = true, AFTER_DRAIN = false;
    unsigned char* ws; int layer; PG8_LAS unsigned char* lds;
    __device__ __forceinline__ void operator()(f32x4 (&acc)[2][2][4][2], const Unit& u, int ui, int wr, int wc, int fr, int fq) const {
        bf16_t* const O = (bf16_t*)(ws + WS_ACT); constexpr int ldc = DIN; const float* const rope = (const float*)(ws + WS_ROPE); float* const ksum = (float*)(ws + WS_KSUM) + (size_t)layer * 65536;
        const int pn = u.pn;
        const int row0 = u.pm * BM + wr * 64 + fr;
        const bool is_rope = (pn == 1) | (pn == 2) | (pn == 4) | (pn == 5);
        const bool do_rope = is_rope && ((wc & 1) == 0);
        const float sc = ((pn == 1) | (pn == 4)) ? C2 : 1.f;
        const int col0 = pn * BM + wc * 32 + 8 * fq;
        float rsv[2][4];
#pragma unroll
        for (int ai = 0; ai < 2; ++ai)
#pragma unroll
            for (int m = 0; m < 4; ++m) rsv[ai][m] = row_rstd(lds, ui, wr * 64 + fr + ai * HALF + m * 16);
        if (ui >= RC_UNITS) {
#pragma unroll
            for (int ai = 0; ai < 2; ++ai)
#pragma unroll
                for (int m = 0; m < 4; ++m) rsv[ai][m] = row_rstd_global((const float*)(ws + WS_SSQ), u.pm * BM + wr * 64 + fr + ai * HALF + m * 16, fq);
        }
        f32x4 ks[2][2];
#pragma unroll
        for (int bj = 0; bj < 2; ++bj)
#pragma unroll
            for (int n = 0; n < 2; ++n) ks[bj][n] = (f32x4){0.f, 0.f, 0.f, 0.f};
#pragma unroll
        for (int ai = 0; ai < 2; ++ai)
#pragma unroll
            for (int m = 0; m < 4; ++m) {
                const int row = row0 + ai * HALF + m * 16;
                {   const float rs = rsv[ai][m];
#pragma unroll
                    for (int bj = 0; bj < 2; ++bj) { acc[ai][bj][m][0] *= rs; acc[ai][bj][m][1] *= rs; } }
                if (do_rope) {
                    const float* tb = rope + (size_t)row * 16;
                    f32x4 cs[2], sn[2];
                    cs[0] = *(const f32x4*)(tb); cs[1] = *(const f32x4*)(tb + 4); sn[0] = *(const f32x4*)(tb + 8); sn[1] = *(const f32x4*)(tb + 12);
#pragma unroll
                    for (int bj = 0; bj < 2; ++bj)
#pragma unroll
                        for (int n = 0; n < 2; ++n) {
                            const f32x4 own = acc[ai][bj][m][n]; f32x4 oth;
#pragma unroll
                            for (int i = 0; i < 4; ++i) oth[i] = __shfl_xor(own[i], 16);
                            const f32x4 sg = (fq == 0) ? -sn[n] : sn[n];
                            const f32x4 res = own * cs[n] + oth * sg;
                            if (fq < 2) acc[ai][bj][m][n] = res;
                        }
                }
                bf16_t* rowp = O + (size_t)row * ldc + col0;
#pragma unroll
                for (int bj = 0; bj < 2; ++bj) {
                    ks[bj][0] += acc[ai][bj][m][0]; ks[bj][1] += acc[ai][bj][m][1];
                    const f32x4 v0 = acc[ai][bj][m][0] * sc, v1 = acc[ai][bj][m][1] * sc;
                    u32x4 w; w.x = cvtpk(v0[0], v0[1]); w.y = cvtpk(v0[2], v0[3]); w.z = cvtpk(v1[0], v1[1]); w.w = cvtpk(v1[2], v1[3]);
                    *(u32x4*)(rowp + bj * HALF) = w;
                }
                asm volatile("" ::: "memory");
            }
        if (pn == 2) {
#pragma unroll
            for (int bj = 0; bj < 2; ++bj)
#pragma unroll
                for (int n = 0; n < 2; ++n) {
                    f32x4 s = ks[bj][n];
#pragma unroll
                    for (int i = 0; i < 4; ++i) { float t = s[i]; t += __shfl_xor(t, 1); t += __shfl_xor(t, 2); t += __shfl_xor(t, 4); t += __shfl_xor(t, 8); s[i] = t; }
                    if (fr == 0) *(f32x4*)(ksum + (size_t)(u.pm * 2 + wr) * 256 + bj * HALF + wc * 32 + 8 * fq + 4 * n) = s;
                }
        }
    }
};
}

__device__ __forceinline__ void transpose_item(const float* W, int K, int N, bf16_t* WT, int mode, LAS float* scr, int item, int lane, const float* gain) {
    const int nblk = N / 32, kb = item / nblk, nb = item % nblk, k0 = 64 * kb, n0 = 32 * nb;
    const int rbase = (mode == 0) ? n0 : (256 * (nb >> 2) + 32 * (nb & 3) + (mode == 2 ? 128 : 0));
    {
        float tv[32], gq[32];
        const float* src = W + (size_t)(k0 + (lane >> 5)) * N + n0 + (lane & 31);
#pragma unroll
        for (int i = 0; i < 32; ++i) tv[i] = src[(size_t)(2 * i) * N];
#pragma unroll
        for (int i = 0; i < 32; ++i) gq[i] = gain ? gain[k0 + 2 * i + (lane >> 5)] : 1.0f;
#pragma unroll
        for (int i = 0; i < 32; ++i) scr[(2 * i + (lane >> 5)) * 33 + (lane & 31)] = tv[i] * gq[i];
    }
    asm volatile("s_waitcnt lgkmcnt(0)" ::: "memory");
    const int c = lane & 7;
#pragma unroll
    for (int j = 0; j < 4; ++j) { const int n = (lane >> 3) + 8 * j; const LAS float* s = scr + (8 * c) * 33 + n;
        u32x4 o; o.x = cvtpk(s[0 * 33], s[1 * 33]); o.y = cvtpk(s[2 * 33], s[3 * 33]); o.z = cvtpk(s[4 * 33], s[5 * 33]); o.w = cvtpk(s[6 * 33], s[7 * 33]);
        *(u32x4*)(WT + (size_t)(rbase + n) * K + k0 + 8 * c) = o; }
    asm volatile("s_waitcnt lgkmcnt(0)" ::: "memory");
}
__device__ __forceinline__ void sincos_acc(float ang, float& c, float& s) {
    const double a = (double)ang;
    const double k = __builtin_rint(a * 0.63661977236758134308);
    double r = __builtin_fma(-k, 1.57079632679489655800, a);
    r = __builtin_fma(-k, 6.12323399573676603587e-17, r);
    const float x = (float)r, x2 = x * x;
    const float sp = x + x * x2 * (-1.6666667e-1f + x2 * (8.3333333e-3f + x2 * (-1.9841270e-4f + x2 * 2.7557319e-6f)));
    const float cp = 1.f + x2 * (-0.5f + x2 * (4.1666667e-2f + x2 * (-1.3888889e-3f + x2 * (2.4801587e-5f + x2 * (-2.7557319e-7f)))));
    const int q = ((int)k) & 3;
    const float s0 = (q & 1) ? cp : sp, c0 = (q & 1) ? sp : cp;
    s = (q & 2) ? -s0 : s0;
    c = (q == 1 || q == 2) ? -c0 : c0;
}
struct Args { const float* in[20]; float* out; unsigned char* ws; int ph_lo, ph_hi; };

__device__ __forceinline__ void prologue(const Args& A, LAS unsigned char* lds, int gw, int NGW, int wave, int lane) {
    LAS float* scr = (LAS float*)(lds + wave * 16384);
    constexpr int I_G = (DM / 64) * (DFF / 32), I_D = (DFF / 64) * (DM / 32), I_IN = (DM / 64) * (DIN / 32), I_OUT = (DM / 64) * (DM / 32);
    constexpr int I_LAYER = 6 * I_G + I_IN + I_OUT;
    static_assert(I_D == I_G, "item counts");
    for (int it = gw; it < DEPTH * I_LAYER; it += NGW) {
        const int l = it / I_LAYER; int r = it % I_LAYER;
        unsigned char* wl = A.ws + WS_W + (size_t)l * W_LAYER;
        if (r < I_G) { transpose_item(A.in[3] + (size_t)l * DM * DFF, DM, DFF, (bf16_t*)(wl + WO_GU1), 1, scr, r, lane, A.in[2] + (size_t)l * DM); continue; } r -= I_G;
        if (r < I_G) { transpose_item(A.in[4] + (size_t)l * DM * DFF, DM, DFF, (bf16_t*)(wl + WO_GU1), 2, scr, r, lane, A.in[2] + (size_t)l * DM); continue; } r -= I_G;
        if (r < I_G) { transpose_item(A.in[5] + (size_t)l * DFF * DM, DFF, DM, (bf16_t*)(wl + WO_D1), 0, scr, r, lane, nullptr); continue; } r -= I_G;
        if (r < I_G) { transpose_item(A.in[16] + (size_t)l * DM * DFF, DM, DFF, (bf16_t*)(wl + WO_GU2), 1, scr, r, lane, A.in[15] + (size_t)l * DM); continue; } r -= I_G;
        if (r < I_G) { transpose_item(A.in[17] + (size_t)l * DM * DFF, DM, DFF, (bf16_t*)(wl + WO_GU2), 2, scr, r, lane, A.in[15] + (size_t)l * DM); continue; } r -= I_G;
        if (r < I_G) { transpose_item(A.in[18] + (size_t)l * DFF * DM, DFF, DM, (bf16_t*)(wl + WO_D2), 0, scr, r, lane, nullptr); continue; } r -= I_G;
        if (r < I_IN) { transpose_item(A.in[7] + (size_t)l * DM * DIN, DM, DIN, (bf16_t*)(wl + WO_IN), 0, scr, r, lane, A.in[6] + (size_t)l * DM); continue; } r -= I_IN;
        transpose_item(A.in[14] + (size_t)l * DM * DM, DM, DM, (bf16_t*)(wl + WO_OUT), 0, scr, r, lane, nullptr);
    }
    {   bf16_t* XB = (bf16_t*)(A.ws + WS_XN); float* SSQ = (float*)(A.ws + WS_SSQ); const float* X0 = A.in[0];
        const int c3 = blockIdx.x, g3 = gridDim.x;
        const int m0 = (g3 == 256) ? 4096 * (c3 & 7) + (c3 >> 3) * 8 + wave : gw;
        const int ms = (g3 == 256) ? 256 : NGW;
        const int me = (g3 == 256) ? 4096 * (c3 & 7) + 4096 : M_TOK;
        for (int mb = m0; mb < me; mb += 4 * ms) {
            f32x4 v[4][4];
#pragma unroll
            for (int q = 0; q < 4; ++q) { const int m = (mb + q * ms < me) ? mb + q * ms : mb; const f32x4* xr = (const f32x4*)(X0 + (size_t)m * DM) + lane;
#pragma unroll
                for (int j = 0; j < 4; ++j) v[q][j] = xr[64 * j]; }
#pragma unroll
            for (int q = 0; q < 4; ++q) { const int m = mb + q * ms; if (m < me) {
                float s = 0.f;
#pragma unroll
                for (int j = 0; j < 4; ++j) s += (v[q][j].x * v[q][j].x + v[q][j].y * v[q][j].y) + (v[q][j].z * v[q][j].z + v[q][j].w * v[q][j].w);
                s = wave_sum(s);
                u32x2* o8 = (u32x2*)(XB + (size_t)m * DM) + lane;
#pragma unroll
                for (int j = 0; j < 4; ++j) { u32x2 w; w.x = cvtpk(v[q][j].x, v[q][j].y); w.y = cvtpk(v[q][j].z, v[q][j].w); o8[64 * j] = w; }
                if (lane < 16) SSQ[(size_t)m * 16 + lane] = (lane == 0) ? s : 0.f; } }
        } }
    const int gt = gw * 64 + lane, NGT = NGW * 64;
    { bf16_t* wpt = (bf16_t*)(A.ws + WS_WPT); const float* pw = A.in[8];
      for (int o = gt; o < DEPTH * 4 * 64 * 64; o += NGT) { const int c = o & 63, d = (o >> 6) & 63, lg = o >> 12; wpt[o] = (bf16_t)(cvtpk(pw[(size_t)lg * 4096 + c * 64 + d], 0.f) & 0xffffu); } }
    { float* rt = (float*)(A.ws + WS_ROPE); const int* pos = (const int*)A.in[1];
      for (int o = gt; o < M_TOK * 8; o += NGT) { const int tok = o >> 3, i = o & 7;
          const float inv = (i == 0) ? 1.0f : (i == 1) ? 0.19392274f : (i == 2) ? 0.03760603f : (i == 3) ? 0.0072926646f : (i == 4) ? 0.0014142136f : (i == 5) ? 0.0002742482f : (i == 6) ? 5.3182957e-05f : 1.0313385e-05f;
          const float ang = (float)pos[tok] * inv; float c, s; sincos_acc(ang, c, s);
          rt[(size_t)tok * 16 + i] = c; rt[(size_t)tok * 16 + 8 + i] = s; } }
}

__device__ __forceinline__ void norm_rows_bf16(const float* X, const float* g, bf16_t* XN, int gw, int NGW, int lane) {
    f32x4 gv[4];
#pragma unroll
    for (int j = 0; j < 4; ++j) gv[j] = ((const f32x4*)g)[lane + 64 * j];
    for (int m = gw; m < M_TOK; m += NGW) {
        const f32x4* xr = (const f32x4*)(X + (size_t)m * DM) + lane; f32x4 v[4]; float s = 0.f;
#pragma unroll
        for (int j = 0; j < 4; ++j) { v[j] = xr[64 * j]; s += (v[j].x * v[j].x + v[j].y * v[j].y) + (v[j].z * v[j].z + v[j].w * v[j].w); }
        const float rstd = 1.0f / sqrtf(wave_sum(s) * (1.f / DM) + RMS_EPS);
        u32x2* o8 = (u32x2*)(XN + (size_t)m * DM) + lane;
#pragma unroll
        for (int j = 0; j < 4; ++j) { const f32x4 y = v[j] * rstd * gv[j]; u32x2 w; w.x = cvtpk(y.x, y.y); w.y = cvtpk(y.z, y.w); o8[64 * j] = w; }
    }
}
__device__ __forceinline__ void norm_rows_f32(const float* X, const float* g, float* OUT, int gw, int NGW, int lane) {
    f32x4 gv[4];
#pragma unroll
    for (int j = 0; j < 4; ++j) gv[j] = ((const f32x4*)g)[lane + 64 * j];
    for (int m = gw; m < M_TOK; m += NGW) {
        const f32x4* xr = (const f32x4*)(X + (size_t)m * DM) + lane; f32x4 v[4]; float s = 0.f;
#pragma unroll
        for (int j = 0; j < 4; ++j) { v[j] = xr[64 * j]; s += (v[j].x * v[j].x + v[j].y * v[j].y) + (v[j].z * v[j].z + v[j].w * v[j].w); }
        const float rstd = 1.0f / sqrtf(wave_sum(s) * (1.f / DM) + RMS_EPS);
        f32x4* o = (f32x4*)(OUT + (size_t)m * DM) + lane;
#pragma unroll
        for (int j = 0; j < 4; ++j) o[64 * j] = v[j] * rstd * gv[j];
    }
}

constexpr int PTR_OFF = 131072 + 1024;
__device__ __forceinline__ const float* ldptr(LAS unsigned char* lds, int i) {
    const unsigned long long v = *(volatile LAS unsigned long long*)(lds + PTR_OFF + 8 * i);
    const unsigned lo = __builtin_amdgcn_readfirstlane((unsigned)v), hi = __builtin_amdgcn_readfirstlane((unsigned)(v >> 32));
    return (const float*)(const __attribute__((address_space(1))) float*)(((unsigned long long)hi << 32) | lo);
}
__device__ __forceinline__ void norm_rows_final(const bf16_t* XB, const float* SSQ, const float* g, float* OUT, int m0, int mstride, int mend, int lane) {
    f32x4 gv[4];
#pragma unroll
    for (int j = 0; j < 4; ++j) gv[j] = ((const f32x4*)g)[lane + 64 * j];
    for (int mb = m0; mb < mend; mb += 4 * mstride) {
        u32x2 v[4][4]; float sq[4];
#pragma unroll
        for (int q = 0; q < 4; ++q) { const int m = (mb + q * mstride < mend) ? mb + q * mstride : mb; const u32x2* xr = (const u32x2*)(XB + (size_t)m * DM) + lane;
#pragma unroll
            for (int j = 0; j < 4; ++j) v[q][j] = xr[64 * j];
            sq[q] = (lane < 16) ? SSQ[(size_t)m * 16 + lane] : 0.f; }
#pragma unroll
        for (int q = 0; q < 4; ++q) { const int m = mb + q * mstride; if (m < mend) {
            float s = sq[q];
            s += __shfl_xor(s, 1); s += __shfl_xor(s, 2); s += __shfl_xor(s, 4); s += __shfl_xor(s, 8);
            s = __shfl(s, 0);
            const float rstd = 1.0f / sqrtf(s * (1.f / DM) + RMS_EPS);
            f32x4* o = (f32x4*)(OUT + (size_t)m * DM) + lane;
#pragma unroll
            for (int j = 0; j < 4; ++j) { const f32x4 x = {__uint_as_float(v[q][j].x << 16), __uint_as_float(v[q][j].x & 0xffff0000u), __uint_as_float(v[q][j].y << 16), __uint_as_float(v[q][j].y & 0xffff0000u)};
                o[64 * j] = x * rstd * gv[j]; } } }
    }
}

typedef short v4i16_t __attribute__((ext_vector_type(4)));
__device__ __forceinline__ s16x4 vtr(const LAS unsigned char* p) { return __builtin_bit_cast(s16x4, __builtin_amdgcn_ds_read_tr16_b64_v4i16((LAS v4i16_t*)p)); }

__device__ __forceinline__ float dil_bias(int d, float s) {
    const unsigned ud = (unsigned)d;
    const float f1 = (ud <= 128u) ? 1.f : 0.f;
    const float f2 = (((d & 3) == 0) & (ud <= 512u)) ? 1.f : 0.f;
    const float f3 = (((d & 15) == 0) & (d >= 0)) ? 1.f : 0.f;
    return s + __builtin_amdgcn_logf(f1 + f2 + f3);
}

template <int kind> __device__ __forceinline__ void attn_unit(LAS unsigned char* lds, const bf16_t* H, bf16_t* MIX, const float* ksum, int b, int h, int qb) {
    int tid_ = threadIdx.x; asm volatile("" : "+v"(tid_));
    const int tid = tid_, lane = tid & 63, r32 = lane & 31, hi = lane >> 5; const int wid = __builtin_amdgcn_readfirstlane(tid >> 6);
    const int qcol = (kind ? 1024 : 256) + h * 64, kcol = qcol + 256, vcol = qcol + 512;
    const size_t rowbase = (size_t)b * SEQ;
    const int qw0 = 256 * qb + 32 * wid, qpos = qw0 + r32;
    const int NT2 = 2 * (qb + 1);
    const int skey = 8 * wid + (lane >> 3);
    const bf16_t* kg = H + (rowbase + skey) * DIN + kcol + (((lane & 7) ^ ((skey >> 1) & 7)) * 8);
    const bf16_t* vg = H + (rowbase + skey) * DIN + vcol + (((lane & 7) ^ (((skey >> 1) & 1) << 2)) * 8);
#define STEP_TILE(t2) (((t2) < 2) ? 4 * qb + 2 * (t2) : 2 * ((t2) - 2))
#define BUF_OFF(t2) (((t2) % 3) * 32768)
#define ATT_DMA(tt) do { const size_t go_ = (size_t)(64 * STEP_TILE(tt)) * DIN; LAS unsigned char* nb_ = lds + BUF_OFF(tt) + wid * 1024; \
        __builtin_amdgcn_global_load_lds((const unsigned*)(kg + go_), (LAS unsigned*)(nb_), 16, 0, 0); \
        __builtin_amdgcn_global_load_lds((const unsigned*)(kg + go_ + (size_t)64 * DIN), (LAS unsigned*)(nb_ + 8192), 16, 0, 0); \
        __builtin_amdgcn_global_load_lds((const unsigned*)(vg + go_), (LAS unsigned*)(nb_ + 16384), 16, 0, 0); \
        __builtin_amdgcn_global_load_lds((const unsigned*)(vg + go_ + (size_t)64 * DIN), (LAS unsigned*)(nb_ + 16384 + 8192), 16, 0, 0); } while (0)
    ATT_DMA(0); ATT_DMA(1);
    bf16x8 qr[4];
    { const bf16_t* qp = H + (rowbase + qpos) * DIN + qcol + hi * 8;
#pragma unroll
      for (int d0 = 0; d0 < 4; ++d0) qr[d0] = *(const bf16x8*)(qp + 16 * d0); }
    unsigned sel = 0;
    if (kind == 0) {
        if (qb <= 3) sel = (1u << qb) - 1u;
        else {
            float g[7];
#pragma unroll
            for (int j = 0; j < 7; ++j) {
                float a = -INFINITY;
                if (j < qb) {
                    const float* k0 = ksum + (size_t)((b * 8 + j) * 2) * 256 + h * 64 + 8 * hi; const float* k1 = k0 + 256;
                    a = 0.f;
#pragma unroll
                    for (int d0 = 0; d0 < 4; ++d0) {
                        const f32x4 ka = *(const f32x4*)(k0 + 16 * d0) + *(const f32x4*)(k1 + 16 * d0), kb = *(const f32x4*)(k0 + 16 * d0 + 4) + *(const f32x4*)(k1 + 16 * d0 + 4);
                        a += bf2f(qr[d0][0]) * ka[0] + bf2f(qr[d0][1]) * ka[1] + bf2f(qr[d0][2]) * ka[2] + bf2f(qr[d0][3]) * ka[3];
                        a += bf2f(qr[d0][4]) * kb[0] + bf2f(qr[d0][5]) * kb[1] + bf2f(qr[d0][6]) * kb[2] + bf2f(qr[d0][7]) * kb[3];
                    }
                    a += __shfl_xor(a, 32);
                }
                g[j] = a;
            }
#pragma unroll
            for (int it = 0; it < 3; ++it) {
                int bi = 0; float bv = g[0];
#pragma unroll
                for (int j = 1; j < 7; ++j) if (g[j] > bv) { bv = g[j]; bi = j; }
                sel |= 1u << bi;
#pragma unroll
                for (int j = 0; j < 7; ++j) g[j] = (j == bi) ? -INFINITY : g[j];
            }
        }
    }
    int vb[2];
    { const int row = 4 * hi + ((lane & 15) >> 2), swz = ((lane >> 3) & 1) << 6;
#pragma unroll
      for (int dh = 0; dh < 2; ++dh) vb[dh] = 16384 + row * 128 + ((64 * dh + 32 * ((lane >> 4) & 1) + 8 * (lane & 3)) ^ swz); }
    const int ksw = (r32 >> 1) & 7;
    int kofs[4];
#pragma unroll
    for (int d0 = 0; d0 < 4; ++d0) kofs[d0] = r32 * 128 + 16 * ((2 * d0 + hi) ^ ksw);
    float bmid[16];
    { const int dq16 = (qpos - 4 * hi) & 15;
#pragma unroll
      for (int r = 0; r < 16; ++r) { const int c = (r & 3) + 8 * (r >> 2); const bool m3 = ((dq16 - c) & 15) == 0, m2 = ((dq16 - c) & 3) == 0;
          bmid[r] = m3 ? 1.f : (m2 ? 0.f : -INFINITY); } }
    __syncthreads();
    float m_run = -INFINITY, l_run = 0.f; f32x16 o[2];
#pragma unroll
    for (int r = 0; r < 16; ++r) { o[0][r] = 0.f; o[1][r] = 0.f; }
    for (int t2 = 0; t2 < 2; ++t2) {
        const int at0 = STEP_TILE(t2);
        const LAS unsigned char* Bt = lds + BUF_OFF(t2);
        if (t2 + 2 < NT2) ATT_DMA(t2 + 2);
        const bool own = true;
        const bool rowsel = ((sel >> (at0 >> 2)) & 1u) != 0u;
        bool skip[2];
#pragma unroll
        for (int s = 0; s < 2; ++s) skip[s] = (64 * (at0 + s)) > qw0 + 31;
        if (kind == 0 && !own) { if (!__any(rowsel)) { skip[0] = true; skip[1] = true; } }
        if (!(skip[0] && skip[1])) {
            f32x16 p[2][2];
#define ATT_QK(s) do { if (skip[s]) { _Pragma("unroll") for (int r = 0; r < 16; ++r) { p[s][0][r] = -INFINITY; p[s][1][r] = -INFINITY; } } else { \
                  \
                bf16x8 kf_[8]; \
                _Pragma("unroll") for (int d0 = 0; d0 < 4; ++d0) { const LAS unsigned char* kp_ = Bt + kofs[d0]; kf_[2 * d0] = *(const LAS bf16x8*)(kp_ + (s) * 8192); kf_[2 * d0 + 1] = *(const LAS bf16x8*)(kp_ + (s) * 8192 + 4096); } \
                __builtin_amdgcn_sched_barrier(0); \
                f32x16 p0, p1; \
                _Pragma("unroll") for (int r = 0; r < 16; ++r) { p0[r] = 0.f; p1[r] = 0.f; } \
                __builtin_amdgcn_s_setprio(1); \
                _Pragma("unroll") for (int d0 = 0; d0 < 4; ++d0) { \
                    p0 = __builtin_amdgcn_mfma_f32_32x32x16_bf16(kf_[2 * d0], qr[d0], p0, 0, 0, 0); \
                    p1 = __builtin_amdgcn_mfma_f32_32x32x16_bf16(kf_[2 * d0 + 1], qr[d0], p1, 0, 0, 0); } \
                __builtin_amdgcn_s_setprio(0); \
                p[s][0] = p0; p[s][1] = p1; } } while (0)
#define ATT_MASK(s) do { if (!skip[s]) { \
                const int kbase = 64 * (at0 + (s)); const int dq = qpos - kbase - 4 * hi; \
                if (kind == 0) { \
                    if (own) { _Pragma("unroll") for (int r = 0; r < 16; ++r) { const int c = (r & 3) + 8 * (r >> 2); if (c > dq) p[s][0][r] = -INFINITY; if (c + 32 > dq) p[s][1][r] = -INFINITY; } } \
                    else if (!rowsel) { _Pragma("unroll") for (int r = 0; r < 16; ++r) { p[s][0][r] = -INFINITY; p[s][1][r] = -INFINITY; } } \
                } else { \
                    const int dmin = qw0 - (kbase + 63), dmax = qw0 + 31 - kbase; \
                    if (dmin > 512) { _Pragma("unroll") for (int r = 0; r < 16; ++r) { const bool m3 = (bmid[r] == 1.f); p[s][0][r] = m3 ? p[s][0][r] : -INFINITY; p[s][1][r] = m3 ? p[s][1][r] : -INFINITY; } } \
                    else if (dmin > 128 && dmax <= 512) { _Pragma("unroll") for (int r = 0; r < 16; ++r) { p[s][0][r] += bmid[r]; p[s][1][r] += bmid[r]; } } \
                    else { _Pragma("unroll") for (int r = 0; r < 16; ++r) { const int c = (r & 3) + 8 * (r >> 2); p[s][0][r] = dil_bias(dq - c, p[s][0][r]); p[s][1][r] = dil_bias(dq - c - 32, p[s][1][r]); } } \
                } } } while (0)
            ATT_QK(0);
            __builtin_amdgcn_sched_barrier(0);
            ATT_QK(1); ATT_MASK(0);
            __builtin_amdgcn_sched_barrier(0);
            ATT_MASK(1);
#undef ATT_QK
#undef ATT_MASK
            float mx = fmaxf(fmaxf(p[0][0][0], p[0][1][0]), fmaxf(p[1][0][0], p[1][1][0]));
#pragma unroll
            for (int r = 1; r < 16; ++r) mx = fmaxf(mx, fmaxf(fmaxf(p[0][0][r], p[0][1][r]), fmaxf(p[1][0][r], p[1][1][r])));
            mx = fmaxf(mx, __shfl_xor(mx, 32));
            const float mnew = fmaxf(m_run, mx);
            const float msafe = (mnew == -INFINITY) ? 0.f : mnew;
            if (__any(mnew > m_run)) {
                const float alpha = fast_exp2(m_run - msafe);
                l_run *= alpha;
#pragma unroll
                for (int r = 0; r < 16; ++r) { o[0][r] *= alpha; o[1][r] *= alpha; }
            }
            m_run = mnew;
            float rs = 0.f;
            const LAS unsigned char* vbase[2];
            {   unsigned b0_ = (unsigned)(size_t)(Bt + vb[0]), b1_ = (unsigned)(size_t)(Bt + vb[1]); asm volatile("" : "+v"(b0_), "+v"(b1_));
                vbase[0] = (const LAS unsigned char*)(size_t)b0_; vbase[1] = (const LAS unsigned char*)(size_t)b1_; }
#pragma unroll
            for (int kk8 = 0; kk8 < 8; ++kk8) {
                const int s = kk8 >> 2, kk = kk8 & 3, hh = kk >> 1, e = 8 * (kk & 1);
                if (skip[s]) continue;
                s16x4 lo[2], hi4[2];
#pragma unroll
                for (int dh = 0; dh < 2; ++dh) { lo[dh] = vtr(vbase[dh] + s * 8192 + kk * 2048); hi4[dh] = vtr(vbase[dh] + s * 8192 + kk * 2048 + 1024); }
                float x[8];
#pragma unroll
                for (int j = 0; j < 8; ++j) { x[j] = fast_exp2(p[s][hh][e + j] - msafe); rs += x[j]; }
                const u32x4 pw = (u32x4){cvtpk(x[0], x[1]), cvtpk(x[2], x[3]), cvtpk(x[4], x[5]), cvtpk(x[6], x[7])};
#pragma unroll
                for (int dh = 0; dh < 2; ++dh) {
                    const bf16x8 vf = (bf16x8){lo[dh][0], lo[dh][1], lo[dh][2], lo[dh][3], hi4[dh][0], hi4[dh][1], hi4[dh][2], hi4[dh][3]};
                    o[dh] = __builtin_amdgcn_mfma_f32_32x32x16_bf16(vf, __builtin_bit_cast(bf16x8, pw), o[dh], 0, 0, 0);
                }
                __builtin_amdgcn_sched_barrier(0);
            }
            l_run += rs;
        }
        __syncthreads();
    }
    for (int t2 = 2; t2 < NT2; ++t2) {
        const int at0 = STEP_TILE(t2);
        const LAS unsigned char* Bt = lds + BUF_OFF(t2);
        if (t2 + 2 < NT2) ATT_DMA(t2 + 2);
        const bool own = false;
        const bool rowsel = ((sel >> (at0 >> 2)) & 1u) != 0u;
        bool skip[2];
#pragma unroll
        for (int s = 0; s < 2; ++s) skip[s] = (64 * (at0 + s)) > qw0 + 31;
        if (kind == 0 && !own) { if (!__any(rowsel)) { skip[0] = true; skip[1] = true; } }
        if (!(skip[0] && skip[1])) {
            f32x16 p[2][2];
#define ATT_QK(s) do { if (skip[s]) { _Pragma("unroll") for (int r = 0; r < 16; ++r) { p[s][0][r] = -INFINITY; p[s][1][r] = -INFINITY; } } else { \
                  \
                bf16x8 kf_[8]; \
                _Pragma("unroll") for (int d0 = 0; d0 < 4; ++d0) { const LAS unsigned char* kp_ = Bt + kofs[d0]; kf_[2 * d0] = *(const LAS bf16x8*)(kp_ + (s) * 8192); kf_[2 * d0 + 1] = *(const LAS bf16x8*)(kp_ + (s) * 8192 + 4096); } \
                __builtin_amdgcn_sched_barrier(0); \
                f32x16 p0, p1; \
                _Pragma("unroll") for (int r = 0; r < 16; ++r) { p0[r] = 0.f; p1[r] = 0.f; } \
                __builtin_amdgcn_s_setprio(1); \
                _Pragma("unroll") for (int d0 = 0; d0 < 4; ++d0) { \
                    p0 = __builtin_amdgcn_mfma_f32_32x32x16_bf16(kf_[2 * d0], qr[d0], p0, 0, 0, 0); \
                    p1 = __builtin_amdgcn_mfma_f32_32x32x16_bf16(kf_[2 * d0 + 1], qr[d0], p1, 0, 0, 0); } \
                __builtin_amdgcn_s_setprio(0); \
                p[s][0] = p0; p[s][1] = p1; } } while (0)
#define ATT_MASK(s) do { if (!skip[s]) { \
                const int kbase = 64 * (at0 + (s)); const int dq = qpos - kbase - 4 * hi; \
                if (kind == 0) { \
                    if (own) { _Pragma("unroll") for (int r = 0; r < 16; ++r) { const int c = (r & 3) + 8 * (r >> 2); if (c > dq) p[s][0][r] = -INFINITY; if (c + 32 > dq) p[s][1][r] = -INFINITY; } } \
                    else if (!rowsel) { _Pragma("unroll") for (int r = 0; r < 16; ++r) { p[s][0][r] = -INFINITY; p[s][1][r] = -INFINITY; } } \
                } else { \
                    const int dmin = qw0 - (kbase + 63), dmax = qw0 + 31 - kbase; \
                    if (dmin > 512) { _Pragma("unroll") for (int r = 0; r < 16; ++r) { const bool m3 = (bmid[r] == 1.f); p[s][0][r] = m3 ? p[s][0][r] : -INFINITY; p[s][1][r] = m3 ? p[s][1][r] : -INFINITY; } } \
                    else if (dmin > 128 && dmax <= 512) { _Pragma("unroll") for (int r = 0; r < 16; ++r) { p[s][0][r] += bmid[r]; p[s][1][r] += bmid[r]; } } \
                    else { _Pragma("unroll") for (int r = 0; r < 16; ++r) { const int c = (r & 3) + 8 * (r >> 2); p[s][0][r] = dil_bias(dq - c, p[s][0][r]); p[s][1][r] = dil_bias(dq - c - 32, p[s][1][r]); } } \
                } } } while (0)
            ATT_QK(0);
            __builtin_amdgcn_sched_barrier(0);
            ATT_QK(1); ATT_MASK(0);
            __builtin_amdgcn_sched_barrier(0);
            ATT_MASK(1);
#undef ATT_QK
#undef ATT_MASK
            float mx = fmaxf(fmaxf(p[0][0][0], p[0][1][0]), fmaxf(p[1][0][0], p[1][1][0]));
#pragma unroll
            for (int r = 1; r < 16; ++r) mx = fmaxf(mx, fmaxf(fmaxf(p[0][0][r], p[0][1][r]), fmaxf(p[1][0][r], p[1][1][r])));
            mx = fmaxf(mx, __shfl_xor(mx, 32));
            const float mnew = fmaxf(m_run, mx);
            const float msafe = (mnew == -INFINITY) ? 0.f : mnew;
            if (__any(mnew > m_run)) {
                const float alpha = fast_exp2(m_run - msafe);
                l_run *= alpha;
#pragma unroll
                for (int r = 0; r < 16; ++r) { o[0][r] *= alpha; o[1][r] *= alpha; }
            }
            m_run = mnew;
            float rs = 0.f;
            const LAS unsigned char* vbase[2];
            {   unsigned b0_ = (unsigned)(size_t)(Bt + vb[0]), b1_ = (unsigned)(size_t)(Bt + vb[1]); asm volatile("" : "+v"(b0_), "+v"(b1_));
                vbase[0] = (const LAS unsigned char*)(size_t)b0_; vbase[1] = (const LAS unsigned char*)(size_t)b1_; }
#pragma unroll
            for (int kk8 = 0; kk8 < 8; ++kk8) {
                const int s = kk8 >> 2, kk = kk8 & 3, hh = kk >> 1, e = 8 * (kk & 1);
                if (skip[s]) continue;
                s16x4 lo[2], hi4[2];
#pragma unroll
                for (int dh = 0; dh < 2; ++dh) { lo[dh] = vtr(vbase[dh] + s * 8192 + kk * 2048); hi4[dh] = vtr(vbase[dh] + s * 8192 + kk * 2048 + 1024); }
                float x[8];
#pragma unroll
                for (int j = 0; j < 8; ++j) { x[j] = fast_exp2(p[s][hh][e + j] - msafe); rs += x[j]; }
                const u32x4 pw = (u32x4){cvtpk(x[0], x[1]), cvtpk(x[2], x[3]), cvtpk(x[4], x[5]), cvtpk(x[6], x[7])};
#pragma unroll
                for (int dh = 0; dh < 2; ++dh) {
                    const bf16x8 vf = (bf16x8){lo[dh][0], lo[dh][1], lo[dh][2], lo[dh][3], hi4[dh][0], hi4[dh][1], hi4[dh][2], hi4[dh][3]};
                    o[dh] = __builtin_amdgcn_mfma_f32_32x32x16_bf16(vf, __builtin_bit_cast(bf16x8, pw), o[dh], 0, 0, 0);
                }
                __builtin_amdgcn_sched_barrier(0);
            }
            l_run += rs;
        }
        __syncthreads();
    }
#undef STEP_TILE
#undef BUF_OFF
#undef ATT_DMA
    l_run += __shfl_xor(l_run, 32);
    const float inv = 1.0f / l_run;
    int tid2 = threadIdx.x; asm volatile("" : "+v"(tid2));
    bf16_t* op = MIX + ((size_t)b * SEQ + 256 * qb + 32 * (tid2 >> 6) + (tid2 & 31)) * DM + 256 + kind * 256 + h * 64 + 4 * ((tid2 >> 5) & 1);
#pragma unroll
    for (int dh = 0; dh < 2; ++dh)
#pragma unroll
        for (int rg = 0; rg < 4; ++rg) {
            u32x2 w; w.x = cvtpk(o[dh][4 * rg] * inv, o[dh][4 * rg + 1] * inv); w.y = cvtpk(o[dh][4 * rg + 2] * inv, o[dh][4 * rg + 3] * inv);
            *(u32x2*)(op + 32 * dh + 8 * rg) = w;
        }
}

__device__ __forceinline__ void pool_units(LAS unsigned char* lds, const bf16_t* H, bf16_t* MIX, const bf16_t* wpt, const float* pscale, int tile0, int ntiles) {
    int tid_ = threadIdx.x; asm volatile("" : "+v"(tid_));
    const int tid = tid_, lane = tid & 63, r32 = lane & 31, hi = lane >> 5; const int wid = __builtin_amdgcn_readfirstlane(tid >> 6);
    LAS unsigned char* ubuf = lds;
    LAS unsigned char* pbuf = lds + 79 * 512;
    u32x4 uv[5];
#define POOL_LOAD(tile_) do { const int row0_ = (tile_) * 64, tl0_ = row0_ & (SEQ - 1); \
        _Pragma("unroll") for (int it = 0; it < 5; ++it) { const int idx = tid + it * NTHREADS, r = idx >> 5, ch = idx & 31; \
            const bool ok = (idx < 79 * 32) && (tl0_ - 15 + r >= 0); \
            uv[it] = *(const u32x4*)(H + (size_t)(row0_ - 15 + (ok ? r : 15)) * DIN + ch * 8); \
            if (!ok) uv[it] = (u32x4){0u, 0u, 0u, 0u}; } } while (0)
    POOL_LOAD(tile0);
    const int gq = wid >> 1, thq = wid & 1;
    bf16x8 bfr[4][2]; float scl[2];
#pragma unroll
    for (int ks = 0; ks < 4; ++ks)
#pragma unroll
        for (int nt = 0; nt < 2; ++nt) bfr[ks][nt] = *(const bf16x8*)(wpt + (size_t)((gq * 64 + 32 * nt + r32) * 64 + 16 * ks + 8 * hi));
#pragma unroll
    for (int nt = 0; nt < 2; ++nt) scl[nt] = pscale[gq * 64 + 32 * nt + r32];
    for (int ti = 0; ti < ntiles; ++ti) {
        const int row0 = (tile0 + ti) * 64, tl0 = row0 & (SEQ - 1);
#pragma unroll
        for (int it = 0; it < 5; ++it) {
            const int idx = tid + it * NTHREADS, r = idx >> 5, ch = idx & 31;
            if (idx < 79 * 32) *(LAS u32x4*)(ubuf + r * 512 + ch * 16) = uv[it];
        }
        __syncthreads();
        if (ti + 1 < ntiles) POOL_LOAD(tile0 + ti + 1);
        {   const int t = tid >> 3, cg8 = tid & 7, g = cg8 >> 1, w = 2 << g;
            const int cnt = (tl0 + t + 1 < w) ? (tl0 + t + 1) : w; const float inv = 1.0f / (float)cnt;
#pragma unroll
            for (int chunk = 0; chunk < 4; ++chunk) {
                const int ch = cg8 * 4 + chunk;
                float s[8];
#pragma unroll
                for (int e = 0; e < 8; ++e) s[e] = 0.f;
                for (int i = 0; i < w; ++i) { const bf16x8 v = *(const LAS bf16x8*)(ubuf + (15 + t - i) * 512 + ch * 16);
#pragma unroll
                    for (int e = 0; e < 8; ++e) s[e] += bf2f(v[e]); }
                const bf16x8 self = *(const LAS bf16x8*)(ubuf + (15 + t) * 512 + ch * 16);
                u32x4 o;
                o.x = cvtpk(s[0] * inv - bf2f(self[0]), s[1] * inv - bf2f(self[1])); o.y = cvtpk(s[2] * inv - bf2f(self[2]), s[3] * inv - bf2f(self[3]));
                o.z = cvtpk(s[4] * inv - bf2f(self[4]), s[5] * inv - bf2f(self[5])); o.w = cvtpk(s[6] * inv - bf2f(self[6]), s[7] * inv - bf2f(self[7]));
                *(LAS u32x4*)(pbuf + g * 9216 + t * 144 + ((cg8 & 1) * 32 + chunk * 8) * 2) = o;
            }
        }
        __syncthreads();
        {   f32x16 acc[2];
#pragma unroll
            for (int r = 0; r < 16; ++r) { acc[0][r] = 0.f; acc[1][r] = 0.f; }
#pragma unroll
            for (int ks = 0; ks < 4; ++ks) {
                const bf16x8 a = *(const LAS bf16x8*)(pbuf + gq * 9216 + (32 * thq + r32) * 144 + (16 * ks + 8 * hi) * 2);
#pragma unroll
                for (int nt = 0; nt < 2; ++nt) acc[nt] = __builtin_amdgcn_mfma_f32_32x32x16_bf16(a, bfr[ks][nt], acc[nt], 0, 0, 0);
            }
#pragma unroll
            for (int nt = 0; nt < 2; ++nt) {
                const int col = gq * 64 + 32 * nt + r32;
#pragma unroll
                for (int r = 0; r < 16; ++r) { const int token = row0 + 32 * thq + crow(r, hi); MIX[(size_t)token * DM + col] = (bf16_t)(cvtpk(acc[nt][r] * scl[nt], 0.f) & 0xffffu); }
            }
        }
        __syncthreads();
    }
#undef POOL_LOAD
}

__device__ __forceinline__ void conv_units(LAS unsigned char* lds, const bf16_t* H, bf16_t* MIX, int layer, int tile0, int ntiles) {
    int tid_ = threadIdx.x; asm volatile("" : "+v"(tid_));
    const int tid = tid_, lane = tid & 63; const int wid = __builtin_amdgcn_readfirstlane(tid >> 6);
    LAS float* hbuf = (LAS float*)lds;
    LAS float* ybuf = (LAS float*)(lds + 62 * 1024);
    bf16x8 av[4], gv4[4];
#define CONV_LOAD(tile_) do { const int row0_ = (tile_) * 32, tl0_ = row0_ & (SEQ - 1); \
        _Pragma("unroll") for (int it = 0; it < 4; ++it) { const int idx = tid + it * NTHREADS, r = idx >> 5, ch = idx & 31; \
            const bool ok = (idx < 62 * 32) && (tl0_ - 30 + r >= 0); \
            const bf16_t* p_ = H + (size_t)(row0_ - 30 + (ok ? r : 30)) * DIN + 1792 + ch * 8; \
            av[it] = *(const bf16x8*)p_; gv4[it] = *(const bf16x8*)(p_ + 256); } } while (0)
    CONV_LOAD(tile0);
    const int c = tid & 255, th = tid >> 8;
    float wv[31];
    {   const float* cw = ldptr(lds, 10) + (size_t)layer * 31 * 256;
#pragma unroll
        for (int j = 0; j < 31; ++j) wv[j] = cw[j * 256 + c]; }
    const float bias = (ldptr(lds, 11) + (size_t)layer * 256)[c];
    const f32x4 gv = ((const f32x4*)(ldptr(lds, 12) + (size_t)layer * 256))[lane], bv = ((const f32x4*)(ldptr(lds, 13) + (size_t)layer * 256))[lane];
    for (int ti = 0; ti < ntiles; ++ti) {
        const int row0 = (tile0 + ti) * 32, tl0 = row0 & (SEQ - 1);
#pragma unroll
        for (int it = 0; it < 4; ++it) {
            const int idx = tid + it * NTHREADS, r = idx >> 5, ch = idx & 31;
            const bool ok = (idx < 62 * 32) && (tl0 - 30 + r >= 0);
            f32x4 h0 = {0.f, 0.f, 0.f, 0.f}, h1 = {0.f, 0.f, 0.f, 0.f};
            if (ok) {
#pragma unroll
                for (int e = 0; e < 4; ++e) { h0[e] = bf2f(av[it][e]) * sigmoidf_(bf2f(gv4[it][e])); h1[e] = bf2f(av[it][4 + e]) * sigmoidf_(bf2f(gv4[it][4 + e])); }
            }
            if (idx < 62 * 32) { *(LAS f32x4*)(hbuf + r * 256 + ch * 8) = h0; *(LAS f32x4*)(hbuf + r * 256 + ch * 8 + 4) = h1; }
        }
        __syncthreads();
        if (ti + 1 < ntiles) CONV_LOAD(tile0 + ti + 1);
#pragma unroll 1
        for (int q8 = 0; q8 < 2; ++q8) {
            const int tb = 16 * th + 8 * q8;
            float hv[38];
#pragma unroll
            for (int i = 0; i < 38; ++i) hv[i] = hbuf[(tb + i) * 256 + c];
            float acc[8];
#pragma unroll
            for (int tt = 0; tt < 8; ++tt) acc[tt] = bias;
#pragma unroll
            for (int j = 0; j < 31; ++j)
#pragma unroll
                for (int tt = 0; tt < 8; ++tt) acc[tt] += wv[j] * hv[tt + j];
#pragma unroll
            for (int tt = 0; tt < 8; ++tt) ybuf[(tb + tt) * 256 + c] = acc[tt];
        }
        __syncthreads();
#pragma unroll
        for (int k = 0; k < 4; ++k) {
            const int t = wid * 4 + k;
            const f32x4 y = *(const LAS f32x4*)(ybuf + t * 256 + 4 * lane);
            const float mu = wave_sum((y.x + y.y) + (y.z + y.w)) * (1.f / 256.f);
            const f32x4 d = y - mu;
            const float var = wave_sum((d.x * d.x + d.y * d.y) + (d.z * d.z + d.w * d.w)) * (1.f / 256.f);
            const float rstd = 1.0f / sqrtf(var + LN_EPS);
            f32x4 z = d * rstd * gv + bv;
#pragma unroll
            for (int e = 0; e < 4; ++e) z[e] = z[e] * sigmoidf_(z[e]);
            u32x2 w; w.x = cvtpk(z.x, z.y); w.y = cvtpk(z.z, z.w);
            *(u32x2*)(MIX + (size_t)(row0 + t) * DM + 768 + 4 * lane) = w;
        }
        __syncthreads();
    }
#undef CONV_LOAD
}

#define XB_TMO      128
#define XB_XCNT(j)  (256  + 64 * (j))
#define XB_XSUB(j)  (1280 + 64 * (j))
#define XB_XGEN(j)  (2304 + 64 * (j))
#define XB_TOP      3328
#define XB_TOPGEN   3392
#define XCD_BAR_WORDS 3456
#define XB_SPIN_CAP (1u << 18)

__device__ __forceinline__ unsigned xb_ld(unsigned* p)              { return __hip_atomic_load(p, __ATOMIC_RELAXED, __HIP_MEMORY_SCOPE_AGENT); }
__device__ __forceinline__ unsigned xb_add(unsigned* p, unsigned v) { return __hip_atomic_fetch_add(p, v, __ATOMIC_RELAXED, __HIP_MEMORY_SCOPE_AGENT); }
__device__ __forceinline__ unsigned xb_xcc_id() { return (unsigned)__builtin_amdgcn_s_getreg((3 << 11) | 20) & 0xFu; }
#define XB_SPIN(cond, bar) do { unsigned _sp = 0; while (cond) { __builtin_amdgcn_s_sleep(1); \
    if ((++_sp & 255u) == 0u) { if (xb_ld(&(bar)[XB_TMO])) break; if (_sp > XB_SPIN_CAP) { atomicAdd(&(bar)[XB_TMO], 1u); break; } } } } while (0)

struct XcdBarrier {
    unsigned* bar; unsigned x;
    volatile LAS unsigned* st;
};

__device__ __forceinline__ XcdBarrier xcd_barrier_post(unsigned* bar, volatile LAS unsigned* st) {
    XcdBarrier b; b.bar = bar; b.x = xb_xcc_id(); b.st = st;
    if (threadIdx.x == 0) (void)xb_add(&bar[XB_XCNT(b.x)], 1u);
    return b;
}
__device__ __forceinline__ void xcd_barrier_complete(unsigned* bar, unsigned x, unsigned& nloc, unsigned& nx) {
    const unsigned G = gridDim.x * gridDim.y * gridDim.z;
    unsigned sum, cnt, mine, sp = 0u;
    for (;;) {
        sum = 0u; cnt = 0u; mine = 0u;
#pragma unroll 1
        for (unsigned j = 0; j < 16; ++j) { const unsigned c = xb_ld(&bar[XB_XCNT(j)]); sum += c; cnt += (c > 0u) ? 1u : 0u; mine = (j == x) ? c : mine; }
        if (sum == G) break;
        __builtin_amdgcn_s_sleep(1);
        if ((++sp & 255u) == 0u) { if (xb_ld(&bar[XB_TMO])) break; if (sp > XB_SPIN_CAP) { atomicAdd(&bar[XB_TMO], 1u); break; } }
    }
    nloc = mine > 0u ? mine : 1u; nx = cnt > 0u ? cnt : 1u;
}

__device__ __forceinline__ void xcd_barrier(const XcdBarrier& b) {
    asm volatile("s_waitcnt vmcnt(0)" ::: "memory");
    __syncthreads();
    if (threadIdx.x == 0) {
        unsigned* bar = b.bar;
        __builtin_amdgcn_s_waitcnt(0);
        unsigned nloc = b.st[0], nx = b.st[1];
        if (nloc == 0u) { xcd_barrier_complete(bar, b.x, nloc, nx); b.st[0] = nloc; b.st[1] = nx; }
        const unsigned old = xb_add(&bar[XB_XSUB(b.x)], 1u);
        const unsigned gen = old / nloc;
        if (old + 1u == (gen + 1u) * nloc) {
            __builtin_amdgcn_fence(__ATOMIC_RELEASE, "agent");
            asm volatile("s_waitcnt vmcnt(0)" ::: "memory");
            const unsigned og = xb_add(&bar[XB_TOP], 1u);
            const unsigned tg = og / nx;
            if (og + 1u == (tg + 1u) * nx) xb_add(&bar[XB_TOPGEN], 1u);
            else XB_SPIN(xb_ld(&bar[XB_TOPGEN]) == tg, bar);
            __builtin_amdgcn_fence(__ATOMIC_ACQUIRE, "agent");
            xb_add(&bar[XB_XGEN(b.x)], 1u);
            asm volatile("s_waitcnt vmcnt(0)" ::: "memory");
        } else {
            XB_SPIN(xb_ld(&bar[XB_XGEN(b.x)]) == gen, bar);
            __builtin_amdgcn_fence(__ATOMIC_ACQUIRE, "agent");
            asm volatile("s_waitcnt vmcnt(0)" ::: "memory");
        }
    }
    __syncthreads();
}

constexpr int N_PHASES = 2 + 7 * DEPTH;
#ifndef REP_MIX
#define REP_MIX 1
#endif
#ifndef REP_NORM
#define REP_NORM 1
#endif
#ifndef REP_G1
#define REP_G1 1
#endif
#ifndef REP_G3
#define REP_G3 1
#endif
#ifndef REP_PRO
#define REP_PRO 1
#endif
#ifndef REP_SYNC
#define REP_SYNC 1
#endif
__global__ void __launch_bounds__(NTHREADS, 2) fwd_megakernel(Args A) {
    extern __shared__ __attribute__((aligned(16))) unsigned char lds_raw[];
    LAS unsigned char* lds = (LAS unsigned char*)lds_raw;
    cg::grid_group grid = cg::this_grid();
    int tid_ = threadIdx.x; asm volatile("" : "+v"(tid_));
    const int tid = tid_, lane = tid & 63; const int wave = __builtin_amdgcn_readfirstlane(tid >> 6);
    const int G = gridDim.x, bx = blockIdx.x;
    const int gw = bx * NWAVES + wave, NGW = G * NWAVES;
    unsigned char* ws = A.ws;
    bf16_t* XN = (bf16_t*)(ws + WS_XN); bf16_t* ACT = (bf16_t*)(ws + WS_ACT); bf16_t* MIXB = (bf16_t*)(ws + WS_MIX); float* SSQ = (float*)(ws + WS_SSQ);
    float* X = A.out;
    int ph0 = 1;
    unsigned* barw = (unsigned*)(ws + WS_BAR);
    volatile LAS unsigned* bst = (volatile LAS unsigned*)(lds + 131072 + 512);
    if (tid == 0) { bst[0] = 0u; bst[1] = 0u;
#pragma unroll
        for (int i = 0; i < 20; ++i) ((LAS unsigned long long*)(lds + PTR_OFF))[i] = (unsigned long long)A.in[i]; }
    __syncthreads();
    if (bx == 0) { for (int i = tid; i < XCD_BAR_WORDS; i += NTHREADS) barw[i] = 0u; }
    for (int rep = 0; rep < REP_PRO; ++rep) prologue(A, lds, gw, NGW, wave, lane);
    grid.sync();
    XcdBarrier xbar = xcd_barrier_post(barw, bst);
    for (int ph = ph0; ph < N_PHASES - 1; ++ph) {
        if (ph > ph0) { for (int rep = 0; rep < REP_SYNC; ++rep) xcd_barrier(xbar); }
        const int l = (ph - 1) / 7, k = (ph - 1) % 7;
        unsigned char* wl = ws + WS_W + (size_t)l * W_LAYER;
        if (k == 0 || k == 5) {
            pg8::Gemm gm{XN, (const bf16_t*)(wl + (k == 0 ? WO_GU1 : WO_GU2)), M_TOK, 2 * DFF, DM};
            pg8::StaticOrder S; S.init(M_TOK, 2 * DFF, G, bx);
            pg8::EpiSwiGLU E{ws, lds};
            pg8::rstd_cache_fill(lds, SSQ, S);
            for (int rep = 0; rep < REP_G1; ++rep) pg8::gemm_phase<pg8::EpiSwiGLU, pg8::StaticOrder, true, true>(lds, gm, S, E);
        } else if (k == 1 || k == 4 || k == 6) {
            const bf16_t* Am = (k == 4) ? MIXB : ACT;
            const bf16_t* Bm = (const bf16_t*)(wl + (k == 1 ? WO_D1 : k == 4 ? WO_OUT : WO_D2));
            pg8::Gemm gm{Am, Bm, M_TOK, DM, (k == 4) ? DM : DFF};
            pg8::StaticOrder S; S.init(M_TOK, DM, G, bx);
            pg8::EpiResid E{X, ws, 0};
#ifndef REP_G2
#define REP_G2 1
#endif
            for (int rep = 0; rep < REP_G2; ++rep) { E.full = ((k == 4) ? 1 : 0) | ((rep < REP_G2 - 1) ? 2 : 0) ; pg8::gemm_phase<pg8::EpiResid, pg8::StaticOrder, true, true>(lds, gm, S, E); }
        } else if (k == 2) {
            pg8::Gemm gm{XN, (const bf16_t*)(wl + WO_IN), M_TOK, DIN, DM};
            pg8::StaticOrder S; S.init(M_TOK, DIN, G, bx);
            pg8::EpiH E{ws, l, lds};
            pg8::rstd_cache_fill(lds, SSQ, S);
            for (int rep = 0; rep < REP_G3; ++rep) pg8::gemm_phase<pg8::EpiH, pg8::StaticOrder, true, true>(lds, gm, S, E);
        } else {
            const bf16_t* Hm = ACT; bf16_t* MIX = MIXB;
            const float* ksum = (const float*)(ws + WS_KSUM) + (size_t)l * 65536;
            for (int rep = 0; rep < REP_MIX; ++rep)
            for (int u0 = bx; u0 < 2560; u0 += G) {
                int u = u0;
                if (G == 256) { const int c = u0 & 255, rnd = u0 >> 8, x = c & 7, y = c >> 3;
                    if (u0 < 1024) u = u0; else if (u0 < 1536) { if (rnd != 4) continue; u = 1024 + x * 64 + 2 * y; } else { if (rnd != 6) continue; u = 1536 + x * 128 + 4 * y; } }
                if (u < 1024) {
                    const int round = u >> 8, c = u & 255;
                    int half, rest_kind, b, h;
                    if (G == 256) { const int x = c & 7, y = c >> 3; half = y & 1; b = 2 * x + ((y >> 1) & 1); h = (y >> 2) & 3; rest_kind = (y >> 4) & 1; }
                    else { half = c & 1; const int rest = c >> 1; rest_kind = rest >> 6; b = (rest >> 2) & 15; h = rest & 3; }
                    const int qb = (round == 0) ? (half ? 6 : 7) : (round == 1) ? (half ? 1 : 0) : (round == 2) ? (half ? 4 : 5) : (half ? 3 : 2);
                    const int kind = (rest_kind + (round >> 1)) & 1;
#ifndef REP_ATTN
#define REP_ATTN 1
#endif
                    for (int ra = 0; ra < REP_ATTN; ++ra) { if (kind) attn_unit<1>(lds, Hm, MIX, ksum, b, h, qb); else attn_unit<0>(lds, Hm, MIX, ksum, b, h, qb); }
                } else if (u < 1536) {
                    pool_units(lds, Hm, MIX, (const bf16_t*)(ws + WS_WPT) + (size_t)l * 16384, ldptr(lds, 9) + (size_t)l * 256, u - 1024, (G == 256) ? 2 : 1);
                } else {
                    conv_units(lds, Hm, MIX, l, u - 1536, (G == 256) ? 4 : 1);
                }
            }
        }
    }
    xcd_barrier(xbar);
    {   int t3 = threadIdx.x; asm volatile("" : "+v"(t3));
        const int w3 = __builtin_amdgcn_readfirstlane(t3 >> 6);
        const int c3 = blockIdx.x, g3 = gridDim.x;
        const int m0 = (g3 == 256) ? 4096 * (c3 & 7) + (c3 >> 3) * 8 + w3 : c3 * NWAVES + w3;
        const int ms = (g3 == 256) ? 256 : g3 * NWAVES;
        const int me = (g3 == 256) ? 4096 * (c3 & 7) + 4096 : M_TOK;
        norm_rows_final(XN, SSQ, ldptr(lds, 19), X, m0, ms, me, t3 & 63); }
}

#ifndef MK_MULTI
#define MK_MULTI 0
#endif
extern "C" void kernel_launch(void* const* d_in, const int* in_sizes, int n_in, void* d_out, int out_size, void* d_ws, size_t ws_size, hipStream_t stream) {
    static int grid = 0;
    if (grid == 0) {
        if (n_in != 20 || in_sizes[0] != M_TOK * DM || out_size != M_TOK * DM || ws_size < WS_END) { fprintf(stderr, "kernel_launch: unexpected shapes (n_in %d, in0 %d, out %d, ws %zu)\n", n_in, n_in > 0 ? in_sizes[0] : -1, out_size, ws_size); grid = -1; return; }
        int dev = 0, cus = 0, per_cu = 0;
        if (hipGetDevice(&dev) != hipSuccess || hipDeviceGetAttribute(&cus, hipDeviceAttributeMultiprocessorCount, dev) != hipSuccess) { grid = -1; return; }
        if (hipFuncSetAttribute((const void*)fwd_megakernel, hipFuncAttributeMaxDynamicSharedMemorySize, LDS_BYTES) != hipSuccess) { fprintf(stderr, "kernel_launch: hipFuncSetAttribute failed\n"); grid = -1; return; }
        if (hipOccupancyMaxActiveBlocksPerMultiprocessor(&per_cu, (const void*)fwd_megakernel, NTHREADS, LDS_BYTES) != hipSuccess || per_cu < 1) { fprintf(stderr, "kernel_launch: occupancy query says %d\n", per_cu); per_cu = 1; }
        (void)hipGetLastError();
        grid = cus * per_cu;
    }
    if (grid < 0) return;
    Args a{};
    for (int i = 0; i < 20; ++i) a.in[i] = (const float*)d_in[i];
    a.out = (float*)d_out; a.ws = (unsigned char*)d_ws;
#if MK_MULTI
    for (int ph = 0; ph < N_PHASES; ++ph) { a.ph_lo = ph; a.ph_hi = ph + 1; hipLaunchKernelGGL(fwd_megakernel, dim3(grid), dim3(NTHREADS), LDS_BYTES, stream, a); }
#else
    a.ph_lo = 0; a.ph_hi = N_PHASES;
    void* args[] = {&a};
    hipError_t e = hipLaunchCooperativeKernel((const void*)fwd_megakernel, dim3(grid), dim3(NTHREADS), args, LDS_BYTES, stream);
    if (e != hipSuccess) fprintf(stderr, "cooperative launch failed: %s (grid %d)\n", hipGetErrorString(e), grid);
#endif
}
```
